# Optimizing an MI355X kernel written in HIP

```python
import math
import jax, jax.numpy as jnp
from jax import lax
import numpy as np

D_MODEL = 1024
BATCH = 4
SEQ = 4096
DEPTH = 2

HEAD_DIM = 64
SB_HEADS = D_MODEL // (2 * HEAD_DIM)
DA_HEADS = D_MODEL // (4 * HEAD_DIM)
SB_WIDTH = SB_HEADS * HEAD_DIM
DA_WIDTH = DA_HEADS * 2 * HEAD_DIM
MIX_WIDTH = SB_WIDTH + DA_WIDTH
QKV_WIDTH = 3 * SB_WIDTH + 3 * DA_WIDTH
ROPE_DIM = HEAD_DIM // 4
ROPE_THETA = 500000.0
BLOCK_Q = 128
N_EXPERTS = 16
N_GROUPS = 4
EXPERTS_PER_GROUP = N_EXPERTS // N_GROUPS
TOP_K = 2
D_FF_EXPERT = 512
PLE_DIM = 256
DEEPNORM_ALPHA = (2 * DEPTH) ** 0.25
DEEPNORM_BETA = (8 * DEPTH) ** -0.25
LN_EPS = 1e-5

kernel_name = "hymba_stickbreak_diffattn_grouped_moe_deepnorm"


def layer_norm(x, g, b):
    xf = x.astype(jnp.float32)
    mu = jnp.mean(xf, axis=-1, keepdims=True)
    var = jnp.mean(jnp.square(xf - mu), axis=-1, keepdims=True)
    y = (xf - mu) * lax.rsqrt(var + LN_EPS) * g.astype(jnp.float32) + b.astype(jnp.float32)
    return y.astype(x.dtype)


def head_rms_norm(x, g, scale=1.0):
    xf = x.astype(jnp.float32)
    y = xf * lax.rsqrt(jnp.mean(jnp.square(xf), axis=-1, keepdims=True) + LN_EPS)
    return (y * (g.astype(jnp.float32) * scale)).astype(x.dtype)


def rope_tables(positions):
    inv_freq = ROPE_THETA ** (-jnp.arange(0, ROPE_DIM, 2, dtype=jnp.float32) / ROPE_DIM)
    ang = positions.astype(jnp.float32)[..., None] * inv_freq
    return jnp.cos(ang), jnp.sin(ang)


def apply_partial_rope(x, cos, sin):
    half = ROPE_DIM // 2
    x1 = x[..., :half].astype(jnp.float32)
    x2 = x[..., half:ROPE_DIM].astype(jnp.float32)
    rot = jnp.concatenate([x1 * cos - x2 * sin, x2 * cos + x1 * sin], axis=-1).astype(x.dtype)
    return jnp.concatenate([rot, x[..., ROPE_DIM:]], axis=-1)


def stick_breaking_attention(q, k, v):
    seq, d = q.shape[2], q.shape[3]
    scale = d ** -0.5
    outs = []
    for blk in range(seq // BLOCK_Q):
        t0, t1 = blk * BLOCK_Q, (blk + 1) * BLOCK_Q
        z = jnp.einsum('bhqd,bhkd->bhqk', q[:, :, t0:t1], k[:, :, :t1]).astype(jnp.float32) * scale
        qpos = t0 + jnp.arange(BLOCK_Q)
        kpos = jnp.arange(t1)
        mask = kpos[None, :] < qpos[:, None]
        log_not = jnp.where(mask, -jax.nn.softplus(z), 0.0)
        tail = lax.cumsum(log_not, axis=3, reverse=True) - log_not
        a = jnp.where(mask, jnp.exp(jax.nn.log_sigmoid(z) + tail), 0.0)
        outs.append(jnp.einsum('bhqk,bhkd->bhqd', a.astype(v.dtype), v[:, :, :t1]))
    return jnp.concatenate(outs, axis=2)


def differential_attention(q, k, v, lam):
    seq, d = q.shape[3], q.shape[4]
    scale = d ** -0.5
    outs = []
    for blk in range(seq // BLOCK_Q):
        t0, t1 = blk * BLOCK_Q, (blk + 1) * BLOCK_Q
        s = jnp.einsum('bhcqd,bhckd->bhcqk', q[:, :, :, t0:t1], k[:, :, :, :t1]).astype(jnp.float32) * scale
        mask = jnp.arange(t1)[None, :] <= (t0 + jnp.arange(BLOCK_Q))[:, None]
        prob = jax.nn.softmax(jnp.where(mask, s, -jnp.inf), axis=-1)
        w = prob[:, :, 0] - lam * prob[:, :, 1]
        outs.append(jnp.einsum('bhqk,bhkd->bhqd', w.astype(v.dtype), v[:, :, :t1]))
    return jnp.concatenate(outs, axis=2)


def grouped_moe(x, router_w, router_b, w_gate, w_up, w_down):
    b, s, d = x.shape
    xt = x.reshape(b * s, d)
    scores = jax.nn.sigmoid((xt @ router_w).astype(jnp.float32))
    sel = (scores + router_b.astype(jnp.float32)).reshape(-1, N_GROUPS, EXPERTS_PER_GROUP)
    group_score = lax.top_k(sel, TOP_K)[0].sum(-1)
    grp = jnp.argmax(group_score, axis=-1)
    in_grp = jnp.take_along_axis(sel, grp[:, None, None], axis=1)[:, 0]
    _, local = lax.top_k(in_grp, TOP_K)
    idx = grp[:, None] * EXPERTS_PER_GROUP + local
    gate = jnp.take_along_axis(scores, idx, axis=-1)
    gate = gate / jnp.sum(gate, axis=-1, keepdims=True)
    combine = jnp.sum(jax.nn.one_hot(idx, N_EXPERTS, dtype=jnp.float32) * gate[..., None], axis=1)
    y = jnp.zeros((b * s, d), jnp.float32)
    for e in range(N_EXPERTS):
        h = jax.nn.silu(xt @ w_gate[e]) * (xt @ w_up[e])
        y = y + combine[:, e:e + 1] * (h @ w_down[e]).astype(jnp.float32)
    return y.reshape(b, s, d).astype(x.dtype)


def setup_inputs(seed: int = 0) -> dict:
    key = jax.random.key(seed)
    ks = jax.random.split(key, 20)
    f32 = jnp.float32
    nrm = lambda k, shape, std: jax.random.normal(k, shape, f32) * std
    offset = jax.random.randint(ks[2], (BATCH, 1), 0, 1024, dtype=jnp.int32)
    positions = offset + jnp.arange(SEQ, dtype=jnp.int32)[None, :]
    return {
        "x": nrm(ks[0], (BATCH, SEQ, D_MODEL), 1.0),
        "p": nrm(ks[1], (DEPTH, BATCH, SEQ, PLE_DIM), 1.0),
        "positions": positions,
        "w_in": nrm(ks[3], (DEPTH, D_MODEL, QKV_WIDTH), D_MODEL ** -0.5),
        "w_o": nrm(ks[4], (DEPTH, MIX_WIDTH, D_MODEL), MIX_WIDTH ** -0.5 * DEEPNORM_BETA),
        "sb_norm_g": 1.0 + nrm(ks[5], (DEPTH, HEAD_DIM), 0.02),
        "da_lambda": nrm(ks[6], (DEPTH, 4, HEAD_DIM), 0.1),
        "da_subln_g": 1.0 + nrm(ks[7], (DEPTH, 2 * HEAD_DIM), 0.02),
        "ln1_g": 1.0 + nrm(ks[8], (DEPTH, D_MODEL), 0.02),
        "ln1_b": nrm(ks[9], (DEPTH, D_MODEL), 0.02),
        "ln2_g": 1.0 + nrm(ks[10], (DEPTH, D_MODEL), 0.02),
        "ln2_b": nrm(ks[11], (DEPTH, D_MODEL), 0.02),
        "router_w": nrm(ks[12], (D_MODEL, N_EXPERTS), D_MODEL ** -0.5),
        "router_b": nrm(ks[13], (N_EXPERTS,), 0.01),
        "w_gate": nrm(ks[14], (DEPTH, N_EXPERTS, D_MODEL, D_FF_EXPERT), D_MODEL ** -0.5),
        "w_up": nrm(ks[15], (DEPTH, N_EXPERTS, D_MODEL, D_FF_EXPERT), D_MODEL ** -0.5 * DEEPNORM_BETA),
        "w_down": nrm(ks[16], (DEPTH, N_EXPERTS, D_FF_EXPERT, D_MODEL), D_FF_EXPERT ** -0.5 * DEEPNORM_BETA),
        "w_ple": nrm(ks[17], (DEPTH, PLE_DIM, D_MODEL), PLE_DIM ** -0.5),
        "w_ple_gate": nrm(ks[18], (DEPTH, D_MODEL, D_MODEL), D_MODEL ** -0.5),
        "b_ple_gate": nrm(ks[19], (DEPTH, D_MODEL), 0.02),
    }


def reference(x, p, positions, w_in, w_o, sb_norm_g, da_lambda, da_subln_g, ln1_g, ln1_b,
              ln2_g, ln2_b, router_w, router_b, w_gate, w_up, w_down, w_ple, w_ple_gate, b_ple_gate):
    b, s, _ = x.shape
    cos, sin = rope_tables(positions)
    cos_da, sin_da = cos[:, None, None], sin[:, None, None]
    for i in range(DEPTH):
        lambda_init = 0.8 - 0.6 * math.exp(-0.3 * i)
        h = x @ w_in[i]
        o = 0
        sb_q, sb_k, sb_v = (h[..., o + j * SB_WIDTH:o + (j + 1) * SB_WIDTH] for j in range(3))
        o = 3 * SB_WIDTH
        da_q, da_k, da_v = (h[..., o + j * DA_WIDTH:o + (j + 1) * DA_WIDTH] for j in range(3))

        to_heads = lambda t: t.reshape(b, s, SB_HEADS, HEAD_DIM).transpose(0, 2, 1, 3)
        sb_out = stick_breaking_attention(to_heads(sb_q), to_heads(sb_k), to_heads(sb_v))
        sb_out = head_rms_norm(sb_out.transpose(0, 2, 1, 3), sb_norm_g[i]).reshape(b, s, SB_WIDTH)

        to_qk = lambda t: t.reshape(b, s, DA_HEADS, 2, HEAD_DIM).transpose(0, 2, 3, 1, 4)
        dq = apply_partial_rope(to_qk(da_q), cos_da, sin_da)
        dk = apply_partial_rope(to_qk(da_k), cos_da, sin_da)
        dv = da_v.reshape(b, s, DA_HEADS, 2 * HEAD_DIM).transpose(0, 2, 1, 3)
        lam_p = da_lambda[i].astype(jnp.float32)
        lam = (jnp.exp(jnp.sum(lam_p[0] * lam_p[1])) - jnp.exp(jnp.sum(lam_p[2] * lam_p[3]))
               + lambda_init)
        da_out = differential_attention(dq, dk, dv, lam)
        da_out = head_rms_norm(da_out.transpose(0, 2, 1, 3), da_subln_g[i], 1.0 - lambda_init)
        da_out = da_out.reshape(b, s, DA_WIDTH)

        mix = jnp.concatenate([sb_out, da_out], axis=-1) @ w_o[i]
        x = layer_norm(DEEPNORM_ALPHA * x + mix, ln1_g[i], ln1_b[i])

        ffn = grouped_moe(x, router_w, router_b, w_gate[i], w_up[i], w_down[i])
        x = layer_norm(DEEPNORM_ALPHA * x + ffn, ln2_g[i], ln2_b[i])

        gate = jax.nn.sigmoid(x @ w_ple_gate[i] + b_ple_gate[i])
        x = x + gate * (p[i] @ w_ple[i])
    return x
```

```cpp
#include <hip/hip_runtime.h>
#include <hip/hip_cooperative_groups.h>
#include <cstdio>
#include <cstdint>
__device__ __forceinline__ int lane_id_opaque() { int l; asm volatile("v_mbcnt_lo_u32_b32 %0, -1, 0\n\tv_mbcnt_hi_u32_b32 %0, -1, %0" : "=v"(l)); return l; }
template <int CTRL> __device__ __forceinline__ float dpp_mov(float v) { return __builtin_bit_cast(float, __builtin_amdgcn_update_dpp(0, __builtin_bit_cast(int, v), CTRL, 0xF, 0xF, true)); }
__device__ __forceinline__ float red16(float v) { v += dpp_mov<0xB1>(v); v += dpp_mov<0x4E>(v); v += dpp_mov<0x141>(v); v += dpp_mov<0x140>(v); return v; }
__device__ __forceinline__ float red32(float v) { v = red16(v); auto r = __builtin_amdgcn_permlane16_swap(__float_as_uint(v), __float_as_uint(v), false, false); return __uint_as_float(r[0]) + __uint_as_float(r[1]); }
__device__ __forceinline__ float red64(float v) { v = red32(v); auto r = __builtin_amdgcn_permlane32_swap(__float_as_uint(v), __float_as_uint(v), false, false); return __uint_as_float(r[0]) + __uint_as_float(r[1]); }
__device__ __forceinline__ float xchg16(float v, int odd_row) { auto r = __builtin_amdgcn_permlane16_swap(__float_as_uint(v), __float_as_uint(v), false, false); return __uint_as_float(odd_row ? r[0] : r[1]); }
namespace pg8 {
#define PG8_LAS __attribute__((address_space(3)))
typedef unsigned short bf16_t;
typedef short bf16x8 __attribute__((ext_vector_type(8)));
typedef float f32x4 __attribute__((ext_vector_type(4)));
typedef unsigned u32x4 __attribute__((ext_vector_type(4)));
constexpr int BM = 256, BK = 64, HALF = 128, HTB = HALF * BK * 2  , STAGE_BYTES = 8 * HTB, NXCD = 8, WGM = 8;

__host__ __device__ __forceinline__ int lds_byte(int r, int c) { const int st = (r >> 4) * 2 + (c >> 5), rr = r & 15, cc = c & 31, ob = rr * 64 + cc * 2; return st * 1024 + (ob ^ (((ob >> 9) & 1) << 5)); }
__host__ __device__ __forceinline__ void stage_rc(int b, int& R, int& C) { const int st = b / 1024, sb = b % 1024, swz = sb ^ (((sb >> 9) & 1) << 5); R = (st >> 1) * 16 + swz / 64; C = (st & 1) * 32 + (swz % 64) / 2; }
__host__ __device__ __forceinline__ int perm32(int rho) { const int n = rho >> 4, i = rho & 15; return 8 * (i >> 2) + 4 * n + (i & 3); }

struct Unit { int pm, pn; };
struct Gemm { const bf16_t* A; const bf16_t* Bt; int M, N, K; };

struct StaticOrder {
    int nM, nN, nwg, G, c;
    __host__ __device__ void init(int M, int N, int G_, int c_) { nM = M / BM; nN = N / BM; nwg = nM * nN; G = G_; c = c_; }
    __host__ __device__ bool next(int i, Unit& u) const {
        const long L = (long)i * G + c; if (L >= nwg) return false;
        int wgid = (int)L; { const int q = nwg / NXCD, r = nwg % NXCD, xcd = wgid % NXCD, off = wgid / NXCD; wgid = (xcd < r ? xcd * (q + 1) : r * (q + 1) + (xcd - r) * q) + off; }
        const int nig = WGM * nN, gid = wgid / nig, fm = gid * WGM, gsz = (nM - fm) < WGM ? (nM - fm) : WGM;
        u.pm = fm + ((wgid % nig) % gsz); u.pn = (wgid % nig) / gsz; return true;
    }
    __device__ __forceinline__ void a_ready(const Unit&) const {}
    __device__ __forceinline__ void done(const Unit&) const {}
};


__device__ __forceinline__ unsigned cvt_pk_bf16(float lo, float hi) { unsigned r; asm volatile("v_cvt_pk_bf16_f32 %0, %1, %2" : "=v"(r) : "v"(lo), "v"(hi)); return r; }
__device__ __forceinline__ u32x4 pack8(const f32x4 v0, const f32x4 v1) { u32x4 w; w.x = cvt_pk_bf16(v0[0], v0[1]); w.y = cvt_pk_bf16(v0[2], v0[3]); w.z = cvt_pk_bf16(v1[0], v1[1]); w.w = cvt_pk_bf16(v1[2], v1[3]); return w; }
__device__ __forceinline__ float bf_lo(unsigned w) { return __uint_as_float(w << 16); }
__device__ __forceinline__ float bf_hi(unsigned w) { return __uint_as_float(w & 0xffff0000u); }
__device__ __forceinline__ float sigmoidf_fast(float z) { return __builtin_amdgcn_rcpf(1.0f + __builtin_amdgcn_exp2f(-1.4426950408889634f * z)); }

struct EpiBf16Plain {
    static constexpr bool PERM = true, AFTER_DRAIN = false;
    bf16_t* O; int ldc;
    __device__ __forceinline__ void operator()(const f32x4 (&acc)[2][2][4][2], const Unit& u, int wr, int wc, int fr, int fq) const {
        const int row0 = u.pm * BM + wr * 64 + fr, col0 = u.pn * BM + wc * 32 + 8 * fq;
#pragma unroll
        for (int ai = 0; ai < 2; ++ai)
#pragma unroll
            for (int m = 0; m < 4; ++m) { bf16_t* rowp = O + (size_t)(row0 + ai * HALF + m * 16) * ldc + col0;
#pragma unroll
                for (int bj = 0; bj < 2; ++bj) *(u32x4*)(rowp + bj * HALF) = pack8(acc[ai][bj][m][0], acc[ai][bj][m][1]); }
    }
};

struct EpiQKV {
    static constexpr bool PERM = true, AFTER_DRAIN = false;
    bf16_t* O; size_t tstride; const float* cs; float qscale;
    __device__ __forceinline__ void operator()(const f32x4 (&acc)[2][2][4][2], const Unit& u, int wr, int wc, int fr, int fq) const {
        const int t = u.pn >> 1; bf16_t* base = O + (size_t)t * tstride;
        const int row0 = u.pm * BM + wr * 64 + fr, col0 = (u.pn & 1) * BM + wc * 32 + 8 * fq;
        const float sc = (t == 0 || t == 3) ? qscale : 1.f;
        const bool rope = (t == 3 || t == 4) && ((wc & 1) == 0);
#pragma unroll
        for (int ai = 0; ai < 2; ++ai)
#pragma unroll
            for (int m = 0; m < 4; ++m) {
                const int row = row0 + ai * HALF + m * 16;
                f32x4 cv0 = (f32x4){1.f, 1.f, 1.f, 1.f}, cv1 = cv0, sv0 = (f32x4){0.f, 0.f, 0.f, 0.f}, sv1 = sv0;
                if (rope) { const f32x4* c = (const f32x4*)(cs + (size_t)row * 16); cv0 = c[0]; cv1 = c[1]; sv0 = c[2]; sv1 = c[3]; }
#pragma unroll
                for (int bj = 0; bj < 2; ++bj) {
                    f32x4 v0 = acc[ai][bj][m][0], v1 = acc[ai][bj][m][1];
                    if (rope) {
                        f32x4 p0, p1;
#pragma unroll
                        for (int e = 0; e < 4; ++e) { p0[e] = xchg16(v0[e], fq & 1); p1[e] = xchg16(v1[e], fq & 1); }
                        if (fq == 0) { v0 = v0 * cv0 - p0 * sv0; v1 = v1 * cv1 - p1 * sv1; }
                        else if (fq == 1) { v0 = v0 * cv0 + p0 * sv0; v1 = v1 * cv1 + p1 * sv1; }
                    }
                    v0 = v0 * sc; v1 = v1 * sc;
                    *(u32x4*)(base + (size_t)row * 512 + col0 + bj * HALF) = pack8(v0, v1);
                }
            }
    }
};

struct EpiOut {
    static constexpr bool PERM = true, AFTER_DRAIN = false;
    const float* xin; float* out; float alpha;
    __device__ __forceinline__ void operator()(const f32x4 (&acc)[2][2][4][2], const Unit& u, int wr, int wc, int fr, int fq) const {
        const int row0 = u.pm * BM + wr * 64 + fr, col0 = u.pn * BM + wc * 32 + 8 * fq;
#pragma unroll
        for (int ai = 0; ai < 2; ++ai)
#pragma unroll
            for (int m = 0; m < 4; ++m) { const size_t off = (size_t)(row0 + ai * HALF + m * 16) * 1024 + col0;
#pragma unroll
                for (int bj = 0; bj < 2; ++bj) { const f32x4 x0 = *(const f32x4*)(xin + off + bj * HALF), x1 = *(const f32x4*)(xin + off + bj * HALF + 4);
                    *(f32x4*)(out + off + bj * HALF) = x0 * alpha + acc[ai][bj][m][0]; *(f32x4*)(out + off + bj * HALF + 4) = x1 * alpha + acc[ai][bj][m][1]; }
                if (m & 1) asm volatile("" ::: "memory"); }
    }
};

struct EpiGateUp {
    static constexpr bool PERM = true, AFTER_DRAIN = false;
    bf16_t* H;
    __device__ __forceinline__ void operator()(const f32x4 (&acc)[2][2][4][2], const Unit& u, int wr, int wc, int fr, int fq) const {
        const int row0 = u.pm * BM + wr * 64 + fr, col0 = (u.pn & 3) * 128 + wc * 32 + 8 * fq;
#pragma unroll
        for (int ai = 0; ai < 2; ++ai)
#pragma unroll
            for (int m = 0; m < 4; ++m) {
                f32x4 h0, h1;
#pragma unroll
                for (int e = 0; e < 4; ++e) { const float g0 = acc[ai][0][m][0][e], g1 = acc[ai][0][m][1][e];
                    h0[e] = g0 * sigmoidf_fast(g0) * acc[ai][1][m][0][e]; h1[e] = g1 * sigmoidf_fast(g1) * acc[ai][1][m][1][e]; }
                *(u32x4*)(H + (size_t)(row0 + ai * HALF + m * 16) * 512 + col0) = pack8(h0, h1);
            }
    }
};

struct EpiDown {
    static constexpr bool PERM = true, AFTER_DRAIN = false;
    bf16_t* YM; const int* pairlist; const float* gw; const PG8_LAS int* tab;
    __device__ __forceinline__ void operator()(const f32x4 (&acc)[2][2][4][2], const Unit& u, int wr, int wc, int fr, int fq) const {
        const int e = u.pn >> 2, cnt = tab[e], tb = tab[16 + e];
        const int slot0 = (u.pm - tb) * BM + wr * 64 + fr, col0 = (u.pn & 3) * BM + wc * 32 + 8 * fq;
#pragma unroll
        for (int ai = 0; ai < 2; ++ai)
#pragma unroll
            for (int m = 0; m < 4; ++m) { const int slot = slot0 + ai * HALF + m * 16;
                if (slot < cnt) { const int pr = pairlist[e * 16384 + slot]; const float g = gw[e * 16384 + slot];
#pragma unroll
                    for (int bj = 0; bj < 2; ++bj) *(u32x4*)(YM + (size_t)pr * 1024 + col0 + bj * HALF) = pack8(acc[ai][bj][m][0] * g, acc[ai][bj][m][1] * g); } }
    }
};

struct EpiPle {
    static constexpr bool PERM = true, AFTER_DRAIN = false;
    float* Y; const bf16_t* U; const float* bias; bf16_t* XB;
    __device__ __forceinline__ void operator()(const f32x4 (&acc)[2][2][4][2], const Unit& u, int wr, int wc, int fr, int fq) const {
        const int row0 = u.pm * BM + wr * 64 + fr, col0 = u.pn * BM + wc * 32 + 8 * fq;
#pragma unroll
        for (int bj = 0; bj < 2; ++bj) {
            const f32x4 bv0 = *(const f32x4*)(bias + col0 + bj * HALF), bv1 = *(const f32x4*)(bias + col0 + bj * HALF + 4);
#pragma unroll
            for (int ai = 0; ai < 2; ++ai)
#pragma unroll
                for (int m = 0; m < 4; ++m) { const size_t off = (size_t)(row0 + ai * HALF + m * 16) * 1024 + col0 + bj * HALF;
                    const f32x4 x0 = *(const f32x4*)(Y + off), x1 = *(const f32x4*)(Y + off + 4);
                    const u32x4 uu = *(const u32x4*)(U + off);
                    const f32x4 u0 = (f32x4){bf_lo(uu.x), bf_hi(uu.x), bf_lo(uu.y), bf_hi(uu.y)}, u1 = (f32x4){bf_lo(uu.z), bf_hi(uu.z), bf_lo(uu.w), bf_hi(uu.w)};
                    const f32x4 z0 = acc[ai][bj][m][0] + bv0, z1 = acc[ai][bj][m][1] + bv1;
                    f32x4 o0, o1;
#pragma unroll
                    for (int e = 0; e < 4; ++e) { o0[e] = x0[e] + sigmoidf_fast(z0[e]) * u0[e]; o1[e] = x1[e] + sigmoidf_fast(z1[e]) * u1[e]; }
                    *(f32x4*)(Y + off) = o0; *(f32x4*)(Y + off + 4) = o1;
                    *(u32x4*)(XB + off) = pack8(o0, o1);
                    if (m & 1) asm volatile("" ::: "memory");
                }
        }
    }
};

struct MoeOrder {
    const PG8_LAS int* tab;
    const PG8_LAS int* tokt;
    int G, c;
    __device__ __forceinline__ bool next(int i, Unit& u) const {
        const int L = i * G + c; if (L >= __builtin_amdgcn_readfirstlane(tab[32]) * 4) return false;
        const int T = L >> 2; int e = 0;
#pragma unroll
        for (int j = 1; j < 16; ++j) e += (T >= __builtin_amdgcn_readfirstlane(tab[16 + j])) ? 1 : 0;
        u.pm = T; u.pn = __builtin_amdgcn_readfirstlane(e * 4 + (L & 3)); return true;
    }
    __device__ __forceinline__ int tok(int k, int r) const { return tokt[k * 256 + r]; }
    __device__ __forceinline__ void a_ready(const Unit&) const {}
    __device__ __forceinline__ void done(const Unit&) const {}
};

template <class Epi, class Sched, bool ALIGN_EPI = false, bool SP2 = false, bool GATHER = false>
__device__ __forceinline__ void gemm_phase(PG8_LAS unsigned char* lds, const Gemm g, const Sched& S, const Epi& E, const int wave_s) {
    const int lane_l = lane_id_opaque();
    int wid_l = wave_s; asm volatile("" : "+s"(wid_l));
    const int lane = lane_l, wid = wid_l, tid = wid * 64 + lane, wr = wid >> 2, wc = wid & 3, fr = lane & 15, fq = lane >> 4;
    const int K = g.K, nt = K / BK;
    unsigned voffA[2], voffB[2];
#pragma unroll
    for (int i = 0; i < 2; ++i) { int R, C; stage_rc(tid * 16 + i * 8192, R, C); const int Rb = Epi::PERM ? ((R & ~31) + perm32(R & 31)) : R;
        voffA[i] = (unsigned)(R * K + C) * 2u; voffB[i] = (unsigned)(Rb * K + C) * 2u; }
    const size_t kstep = (size_t)(BK * 2);
    const size_t hstep = (size_t)HALF * K * 2;
    const size_t tstep = 2 * hstep;
    const size_t hstepA = GATHER ? (size_t)0 : hstep, tstepA = GATHER ? (size_t)0 : tstep;
    unsigned voG[2][2] = {{0u, 0u}, {0u, 0u}};
#define PG8_GLOAD(k) do { _Pragma("unroll") for (int _h = 0; _h < 2; ++_h) _Pragma("unroll") for (int _i = 0; _i < 2; ++_i) { int _R, _C; stage_rc(tid * 16 + _i * 8192, _R, _C); voG[_h][_i] = (unsigned)(S.tok((k), _h * HALF + _R) * K + _C) * 2u; } } while (0)
#define PG8_STAGEA(bufoff, gbase, h) do { if constexpr (GATHER) { PG8_STAGE(bufoff, gbase, voG[h]); } else { PG8_STAGE(bufoff, (gbase) + (h) * hstep, voffA); } } while (0)
    const unsigned ldsw = (unsigned)wid * 1024u;
    const int aoff = lds_byte(wr * 64 + fr, fq * 8), boff = lds_byte(wc * 32 + fr, fq * 8);
#define PG8_SA(b, h) (((b) * 2 + (h)) * HTB)
#define PG8_SB(b, h) ((4 + (b) * 2 + (h)) * HTB)
#define PG8_STAGE(bufoff, gbase, voff) do { _Pragma("unroll") for (int _i = 0; _i < 2; ++_i) \
        __builtin_amdgcn_global_load_lds((const unsigned*)((const char*)(gbase) + (voff)[_i]), (PG8_LAS unsigned*)(lds + (bufoff) + ldsw + _i * 8192), 16, 0, 0); } while (0)
#define PG8_LDA(dst, b, h) do { _Pragma("unroll") for (int m = 0; m < 4; ++m) _Pragma("unroll") for (int k = 0; k < 2; ++k) dst[m][k] = *(const PG8_LAS bf16x8*)(lds + PG8_SA(b, h) + aoff + m * 2048 + k * 1024); } while (0)
#define PG8_LDB(dst, b, h) do { _Pragma("unroll") for (int n = 0; n < 2; ++n) _Pragma("unroll") for (int k = 0; k < 2; ++k) dst[n][k] = *(const PG8_LAS bf16x8*)(lds + PG8_SB(b, h) + boff + n * 2048 + k * 1024); } while (0)
#define PG8_MMA(ai, bj, At, Bt) do { __builtin_amdgcn_s_setprio(1); _Pragma("unroll") for (int m = 0; m < 4; ++m) _Pragma("unroll") for (int n = 0; n < 2; ++n) _Pragma("unroll") for (int k = 0; k < 2; ++k) \
        acc[ai][bj][m][n] = __builtin_amdgcn_mfma_f32_16x16x32_bf16(Bt[n][k], At[m][k], acc[ai][bj][m][n], 0, 0, 0); __builtin_amdgcn_s_setprio(0); } while (0)
#define PG8_WAIT_V(n) asm volatile("s_waitcnt vmcnt(" #n ")" ::: "memory")
#define PG8_WAIT_L(n) asm volatile("s_waitcnt lgkmcnt(" #n ")" ::: "memory")
#define PG8_BAR __builtin_amdgcn_s_barrier()
#define PG8_SCHED __builtin_amdgcn_sched_barrier(0)
    Unit cur, nxt; int ui = 0;
    if (!S.next(0, cur)) return;
    f32x4 acc[2][2][4][2];
#pragma unroll
    for (int a = 0; a < 2; ++a)
#pragma unroll
        for (int b = 0; b < 2; ++b)
#pragma unroll
            for (int m = 0; m < 4; ++m)
#pragma unroll
                for (int n = 0; n < 2; ++n) acc[a][b][m][n] = (f32x4){0.f, 0.f, 0.f, 0.f};
    bf16x8 At[4][2], B0[2][2], B1[2][2];
    const char* cA = (const char*)g.A + (size_t)cur.pm * tstepA; const char* cB = (const char*)g.Bt + (size_t)cur.pn * tstep;
    S.a_ready(cur);
    if constexpr (GATHER) { PG8_GLOAD(0); }
    if constexpr (SP2) {
        PG8_STAGE(PG8_SB(0, 0), cB, voffB); PG8_STAGE(PG8_SB(0, 1), cB + hstep, voffB); PG8_STAGEA(PG8_SA(0, 0), cA, 0); PG8_STAGEA(PG8_SA(0, 1), cA, 1);
        if (wr == 1) PG8_BAR;
        PG8_WAIT_V(2); PG8_BAR;
        PG8_STAGE(PG8_SB(1, 0), cB + kstep, voffB); PG8_STAGEA(PG8_SA(1, 0), cA + kstep, 0); PG8_STAGE(PG8_SB(1, 1), cB + hstep + kstep, voffB);
        PG8_WAIT_V(6); PG8_BAR;
    } else {
        PG8_STAGE(PG8_SB(0, 0), cB, voffB); PG8_STAGEA(PG8_SA(0, 0), cA, 0); PG8_STAGE(PG8_SB(0, 1), cB + hstep, voffB); PG8_STAGEA(PG8_SA(0, 1), cA, 1);
        if (wr == 1) PG8_BAR;
        PG8_WAIT_V(4); PG8_BAR;
        PG8_STAGE(PG8_SB(1, 0), cB + kstep, voffB); PG8_STAGEA(PG8_SA(1, 0), cA + kstep, 0); PG8_STAGE(PG8_SB(1, 1), cB + hstep + kstep, voffB);
        PG8_WAIT_V(6); PG8_BAR;
    }
    for (;;) {
        const bool has_next = S.next(ui + 1, nxt);
        const char* nA = has_next ? (const char*)g.A + (size_t)nxt.pm * tstepA : cA; const char* nB = has_next ? (const char*)g.Bt + (size_t)nxt.pn * tstep : cB;
        for (int t = 0; t < nt; t += 2) {
            const bool last = (t == nt - 2);
            const char* a1 = cA + (size_t)(t + 1) * kstep;
            const char* a2 = last ? nA : cA + (size_t)(t + 2) * kstep; const char* b2 = last ? nB : cB + (size_t)(t + 2) * kstep;
            const char* a3 = a2 + kstep; const char* b3 = b2 + kstep;
            if (last && has_next) S.a_ready(nxt);
            if constexpr (SP2) {
            PG8_LDB(B0, 0, 0); PG8_LDB(B1, 0, 1); PG8_SCHED; PG8_LDA(At, 0, 0); PG8_STAGEA(PG8_SA(1, 1), a1, 1);
            if constexpr (GATHER) { if (last && has_next) { PG8_GLOAD(ui + 1); } }
            PG8_WAIT_V(8); PG8_WAIT_L(0); PG8_BAR; PG8_MMA(0, 0, At, B0); PG8_MMA(0, 1, At, B1); PG8_BAR; PG8_SCHED;
            PG8_LDA(At, 0, 1); PG8_STAGE(PG8_SB(0, 0), b2, voffB); PG8_STAGE(PG8_SB(0, 1), b2 + hstep, voffB); PG8_STAGEA(PG8_SA(0, 0), a2, 0);
            PG8_WAIT_V(8); PG8_WAIT_L(0); PG8_BAR; PG8_MMA(1, 0, At, B0); PG8_MMA(1, 1, At, B1); PG8_BAR; PG8_SCHED;
            PG8_LDB(B0, 1, 0); PG8_LDB(B1, 1, 1); PG8_SCHED; PG8_LDA(At, 1, 0); PG8_STAGEA(PG8_SA(0, 1), a2, 1);
            PG8_WAIT_V(8); PG8_WAIT_L(0); PG8_BAR; PG8_MMA(0, 0, At, B0); PG8_MMA(0, 1, At, B1); PG8_BAR; PG8_SCHED;
            PG8_LDA(At, 1, 1); PG8_STAGE(PG8_SB(1, 0), b3, voffB); PG8_STAGE(PG8_SB(1, 1), b3 + hstep, voffB); PG8_STAGEA(PG8_SA(1, 0), a3, 0);
            PG8_WAIT_V(8); PG8_WAIT_L(0); PG8_BAR; PG8_MMA(1, 0, At, B0); PG8_MMA(1, 1, At, B1); PG8_BAR; PG8_SCHED;
            } else {
            PG8_LDB(B0, 0, 0); PG8_SCHED; PG8_LDA(At, 0, 0); PG8_STAGEA(PG8_SA(1, 1), a1, 1);
            if constexpr (GATHER) { if (last && has_next) { PG8_GLOAD(ui + 1); } }
            PG8_WAIT_L(8); PG8_BAR; PG8_WAIT_L(0); PG8_MMA(0, 0, At, B0); PG8_BAR; PG8_SCHED;
            PG8_LDB(B1, 0, 1); PG8_STAGE(PG8_SB(0, 0), b2, voffB);
            PG8_BAR; PG8_WAIT_L(0); PG8_MMA(0, 1, At, B1); PG8_BAR;
            PG8_LDA(At, 0, 1); PG8_STAGEA(PG8_SA(0, 0), a2, 0);
            PG8_BAR; PG8_WAIT_L(0); PG8_MMA(1, 0, At, B0); PG8_BAR; PG8_SCHED;
            PG8_STAGE(PG8_SB(0, 1), b2 + hstep, voffB);
            PG8_WAIT_V(6); PG8_BAR; PG8_MMA(1, 1, At, B1); PG8_BAR;
            PG8_LDB(B0, 1, 0); PG8_SCHED; PG8_LDA(At, 1, 0); PG8_STAGEA(PG8_SA(0, 1), a2, 1);
            PG8_WAIT_L(8); PG8_BAR; PG8_WAIT_L(0); PG8_MMA(0, 0, At, B0); PG8_BAR; PG8_SCHED;
            PG8_LDB(B1, 1, 1); PG8_STAGE(PG8_SB(1, 0), b3, voffB);
            PG8_BAR; PG8_WAIT_L(0); PG8_MMA(0, 1, At, B1); PG8_BAR;
            PG8_LDA(At, 1, 1); PG8_STAGEA(PG8_SA(1, 0), a3, 0);
            PG8_BAR; PG8_WAIT_L(0); PG8_MMA(1, 0, At, B0); PG8_BAR; PG8_SCHED;
            PG8_STAGE(PG8_SB(1, 1), b3 + hstep, voffB);
            PG8_WAIT_V(6); PG8_BAR; PG8_MMA(1, 1, At, B1); PG8_BAR;
            }
        }
        if constexpr (ALIGN_EPI) { if (wr == 0) PG8_BAR; }
        if constexpr (!Epi::AFTER_DRAIN) { { const int l2_ = lane_id_opaque(); E(acc, cur, wr, wc, l2_ & 15, l2_ >> 4); }     S.done(cur); }
        if (!has_next) break;
#pragma unroll
        for (int a = 0; a < 2; ++a)
#pragma unroll
            for (int b = 0; b < 2; ++b)
#pragma unroll
                for (int m = 0; m < 4; ++m)
#pragma unroll
                    for (int n = 0; n < 2; ++n) acc[a][b][m][n] = (f32x4){0.f, 0.f, 0.f, 0.f};
        cur = nxt; cA = nA; cB = nB; ++ui;
        if constexpr (ALIGN_EPI) { if (wr == 1) PG8_BAR; }
    }
    PG8_WAIT_V(0);
    if constexpr (!ALIGN_EPI) { if (wr == 0) PG8_BAR; }
    PG8_BAR;
    if constexpr (Epi::AFTER_DRAIN) { E.fused(acc, cur, wr, wc, fr, fq, lds, wid, lane); S.done(cur); }
#undef PG8_SA
#undef PG8_SB
#undef PG8_STAGE
#undef PG8_STAGEA
#undef PG8_GLOAD
#undef PG8_LDA
#undef PG8_LDB
#undef PG8_MMA
#undef PG8_WAIT_V
#undef PG8_WAIT_L
#undef PG8_BAR
#undef PG8_SCHED
}
}

#include <hip/hip_bf16.h>
#include <cmath>
#include <hip/hip_bf16.h>
#include <cmath>
namespace attn_body {
using bf16=__hip_bfloat16;
using bf16x8=__attribute__((ext_vector_type(8)))short;
using s16x4=__attribute__((ext_vector_type(4)))short;
using f32x16=__attribute__((ext_vector_type(16)))float;
using u32x4=__attribute__((ext_vector_type(4)))unsigned;
constexpr int D=64;
constexpr int NW=8,QBLK=32,QB=QBLK*NW,KVBLK=64;
constexpr int ATTN_UNIT_ROWS=QB;
__device__ __forceinline__ int crow(int r,int hi){return (r&3)+8*(r>>2)+4*hi;}
#define SBAR() __builtin_amdgcn_sched_barrier(0)
__device__ __forceinline__ void cmask(f32x16&p0,f32x16&p1,int jb,int qrel,int hi){
  const float NEG=-INFINITY; int kb=64*jb+4*hi;
  #pragma unroll
  for(int r=0;r<16;++r){int kv=kb+(r&3)+8*(r>>2); if(kv>qrel)p0[r]=NEG; if(kv+32>qrel)p1[r]=NEG;}
}

constexpr int NSLOT=3, SLOTB=8192;
constexpr int LDS_K=0, LDS_V=NSLOT*SLOTB, LDS_WS=2*NSLOT*SLOTB, LDS_OST=LDS_WS+NW*64*4, LDS_BYTES=LDS_OST+NW*4096;
constexpr float C2=0.125f*1.4426950408889634f;
__device__ __forceinline__ void glds16(const void*gsrc,unsigned lds_dst){unsigned keep;
  asm volatile("s_mov_b32 %0, m0\n\ts_mov_b32 m0, %2\n\ts_nop 0\n\tglobal_load_lds_dwordx4 %1, off\n\ts_mov_b32 m0, %0":"=&s"(keep):"v"(gsrc),"s"(lds_dst):"memory");}
__device__ __forceinline__ float max3f(float a,float b,float c){float r;asm("v_max3_f32 %0, %1, %2, %3":"=v"(r):"v"(a),"v"(b),"v"(c));return r;}
__device__ __forceinline__ float max2f(float a,float b){float r;asm("v_max_f32_e32 %0, %1, %2":"=v"(r):"v"(a),"v"(b));return r;}
__device__ __forceinline__ float fadd_s(float a,float b){float r;asm("v_add_f32_e32 %0, %1, %2":"=v"(r):"v"(a),"v"(b));return r;}
__device__ __forceinline__ float fsub_s(float a,float b){float r;asm("v_sub_f32_e32 %0, %1, %2":"=v"(r):"v"(a),"v"(b));return r;}
typedef float f32x2_t __attribute__((ext_vector_type(2))); typedef __bf16 bf16x2_t __attribute__((ext_vector_type(2)));
__device__ __forceinline__ unsigned cvtpk_s(float lo,float hi){f32x2_t v={lo,hi};bf16x2_t b=__builtin_convertvector(v,bf16x2_t);return __builtin_bit_cast(unsigned,b);}
#define WAIT_BAR(N) asm volatile("s_waitcnt vmcnt(" #N ") lgkmcnt(0)\n\ts_barrier":::"memory")

__device__ __forceinline__ void qkt(f32x16&p0,f32x16&p1,const char*Kslot,const bf16x8*qr,const f32x16&negm,int r32,int hi){
  const char*kb=Kslot+hi*1024+r32*16;
  #pragma unroll
  for(int d0=0;d0<4;++d0){
    const bf16x8 b0=*reinterpret_cast<const bf16x8*>(kb+d0*2048);
    const bf16x8 b1=*reinterpret_cast<const bf16x8*>(kb+d0*2048+512);
    if(d0==0){p0=__builtin_amdgcn_mfma_f32_32x32x16_bf16(b0,qr[0],negm,0,0,0);p1=__builtin_amdgcn_mfma_f32_32x32x16_bf16(b1,qr[0],negm,0,0,0);}
    else{p0=__builtin_amdgcn_mfma_f32_32x32x16_bf16(b0,qr[d0],p0,0,0,0);p1=__builtin_amdgcn_mfma_f32_32x32x16_bf16(b1,qr[d0],p1,0,0,0);}}
}
typedef __attribute__((address_space(3))) const char* lds_cptr;
typedef short v4i16_t __attribute__((ext_vector_type(4)));
__device__ __forceinline__ void kload8(bf16x8*kf,lds_cptr kp){
  kf[0]=*(const __attribute__((address_space(3))) bf16x8*)(kp);      kf[1]=*(const __attribute__((address_space(3))) bf16x8*)(kp+512);
  kf[2]=*(const __attribute__((address_space(3))) bf16x8*)(kp+2048); kf[3]=*(const __attribute__((address_space(3))) bf16x8*)(kp+2560);
  kf[4]=*(const __attribute__((address_space(3))) bf16x8*)(kp+4096); kf[5]=*(const __attribute__((address_space(3))) bf16x8*)(kp+4608);
  kf[6]=*(const __attribute__((address_space(3))) bf16x8*)(kp+6144); kf[7]=*(const __attribute__((address_space(3))) bf16x8*)(kp+6656);
}
__device__ __forceinline__ void kload2(bf16x8*kf,lds_cptr kp,int j){ kf[2*j]=*(const __attribute__((address_space(3))) bf16x8*)(kp+j*2048); kf[2*j+1]=*(const __attribute__((address_space(3))) bf16x8*)(kp+j*2048+512); }
__device__ __forceinline__ s16x4 vtr(lds_cptr p){ return __builtin_bit_cast(s16x4,__builtin_amdgcn_ds_read_tr16_b64_v4i16((__attribute__((address_space(3))) v4i16_t*)p)); }
__device__ __forceinline__ float rowmax(const f32x16&p0,const f32x16&p1){
  float a=max3f(p0[0],p0[1],p1[0]),b=max3f(p0[2],p0[3],p1[1]);a=max3f(a,p1[2],p1[3]);
  #pragma unroll
  for(int r=4;r<16;r+=4){a=max3f(a,p0[r],p0[r+1]);b=max3f(b,p0[r+2],p0[r+3]);a=max3f(a,p1[r],p1[r+1]);b=max3f(b,p1[r+2],p1[r+3]);}
  const float m=max2f(a,b);
  auto rr=__builtin_amdgcn_permlane32_swap(__float_as_uint(m),__float_as_uint(m),false,false);
  return max2f(__uint_as_float(rr[0]),__uint_as_float(rr[1]));
}
__device__ __forceinline__ void pv(f32x16*o,int vb,bf16x8 pa0,bf16x8 pa1,bf16x8 pa2,bf16x8 pa3){
  #pragma unroll
  for(int d0=0;d0<2;++d0){s16x4 lo[4],hi[4];
    #pragma unroll
    for(int ks=0;ks<4;++ks){
      asm volatile("ds_read_b64_tr_b16 %0,%1 offset:%c2":"=&v"(lo[ks]):"v"(vb),"i"(d0*4096+ks*1024):"memory");
      asm volatile("ds_read_b64_tr_b16 %0,%1 offset:%c2":"=&v"(hi[ks]):"v"(vb),"i"(d0*4096+ks*1024+512):"memory");}
    asm volatile("s_waitcnt lgkmcnt(0)":::"memory");SBAR();
    #define PK(k) (bf16x8){lo[k][0],lo[k][1],lo[k][2],lo[k][3],hi[k][0],hi[k][1],hi[k][2],hi[k][3]}
    o[d0]=__builtin_amdgcn_mfma_f32_32x32x16_bf16(pa0,PK(0),o[d0],0,0,0);
    o[d0]=__builtin_amdgcn_mfma_f32_32x32x16_bf16(pa1,PK(1),o[d0],0,0,0);
    o[d0]=__builtin_amdgcn_mfma_f32_32x32x16_bf16(pa2,PK(2),o[d0],0,0,0);
    o[d0]=__builtin_amdgcn_mfma_f32_32x32x16_bf16(pa3,PK(3),o[d0],0,0,0);
    #undef PK
  }
}

#ifndef ATTN_STORE16
#define ATTN_STORE16(p,v) (*(u32x4*)(p)=(v))
#endif
template<int THRL,int QKP,int VP,int OP> __device__ __forceinline__ void attn_unit(int qb,const bf16*Qh,const bf16*__restrict__ Kh_,const bf16*__restrict__ Vh_,bf16*Oh,char*shm,const int wave_s){
  const int lane_l=lane_id_opaque(); const int lane=lane_l,r32=lane&31,hi=lane>>5; int wid_l=wave_s; asm volatile("":"+s"(wid_l)); const int wid=wid_l; const int tid=wid*64+lane; (void)tid;
  const int q0=qb*QB;
  const bf16*Qw=Qh+(long)(q0+wid*QBLK)*QKP;
  const bf16*Kh=Kh_,*Vh=Vh_;
  const unsigned lds0=(unsigned)(uintptr_t)shm;
  float*wsf=(float*)(shm+LDS_WS)+wid*64;
  const bf16*ksrc=Kh+(long)lane*QKP+wid*8;
  const bf16*vsrc=Vh+(long)(16*(wid&3)+(lane>>2))*VP+(wid>>2)*32+(lane&3)*8;
  const unsigned kdst=lds0+LDS_K+wid*1024, vdst=lds0+LDS_V+wid*1024;
  #define DMA_K(t,slot) glds16(ksrc+(long)(t)*KVBLK*QKP,(unsigned)__builtin_amdgcn_readfirstlane(kdst+(slot)))
  #define DMA_V(t,slot) glds16(vsrc+(long)(t)*KVBLK*VP,(unsigned)__builtin_amdgcn_readfirstlane(vdst+(slot)))
  const int vb0=(int)(lds0+LDS_V)+((lane>>4)&1)*32+(lane&3)*8+(4*hi+((lane&15)>>2))*64;
  const char*Kbase=shm+LDS_K; bf16x8 kf[8];
  const lds_cptr shm3=(lds_cptr)shm; const lds_cptr kp0=shm3+LDS_K+hi*1024+r32*16; const lds_cptr vp0=shm3+LDS_V+((lane>>4)&1)*32+(lane&3)*8+(4*hi+((lane&15)>>2))*64;
  const int NT=(q0+QB)/KVBLK;
  DMA_K(0,0);DMA_V(0,0);DMA_K(1,SLOTB);
  bf16x8 qr[4];
  #pragma unroll
  for(int d0=0;d0<4;++d0)qr[d0]=*reinterpret_cast<const bf16x8*>(&Qw[(long)r32*QKP+d0*16+hi*8]);
  float mhat=0.f,l_reg=0.f;float zl_=0.f;asm volatile("":"+v"(zl_));
  f32x16 o[2],negm;
  #pragma unroll
  for(int r=0;r<16;++r){o[0][r]=zl_;o[1][r]=zl_;negm[r]=zl_;}
  asm volatile("":"+v"(negm));
  const int qrel=wid*QBLK+r32;
  #define CMASK(P0,P1,t) do{int jb_=(t)-(NT-4); if(jb_>=0)cmask(P0,P1,jb_,qrel,hi);}while(0)
  bool resc=false;
  #define START(P0,P1) do{ const float rm=rowmax(P0,P1); resc=false; \
    { const float dl=rm; mhat=fadd_s(mhat,dl); \
      _Pragma("unroll") for(int r=0;r<16;++r){P0[r]=fsub_s(P0[r],dl);P1[r]=fsub_s(P1[r],dl);} \
      _Pragma("unroll") for(int r=0;r<16;++r)negm[r]=-mhat; asm volatile("":"+v"(negm)); } \
    _Pragma("unroll") for(int r=0;r<16;++r)P0[r]=__builtin_amdgcn_exp2f(P0[r]); }while(0)
  #define RESC() do{ if(resc){ asm volatile("s_waitcnt lgkmcnt(0)":::"memory"); \
      _Pragma("unroll") for(int d_=0;d_<2;++d_) _Pragma("unroll") for(int r=0;r<16;++r)o[d_][r]*=wsf[crow(r,hi)]; } }while(0)
  f32x16 pA0,pA1,pB0,pB1;
  int sl_prev=0,sl_cur=0,sl_next=SLOTB;
  #define ROT() do{sl_prev=sl_cur;sl_cur=sl_next;sl_next=(sl_next==(NSLOT-1)*SLOTB)?0:sl_next+SLOTB;}while(0)
  DMA_K(2,2*SLOTB);
  WAIT_BAR(3);
  qkt(pA0,pA1,Kbase,qr,negm,r32,hi);asm volatile("s_nop 15\n\ts_nop 7":"+v"(pA0),"+v"(pA1));CMASK(pA0,pA1,0);
  START(pA0,pA1);
  _Pragma("unroll") for(int r=0;r<16;++r)pA1[r]=__builtin_amdgcn_exp2f(pA1[r]);
  WAIT_BAR(0);
  DMA_K(3,0);DMA_V(1,SLOTB);
  ROT();
  kload8(kf,kp0+sl_cur);
  WAIT_BAR(2);
  s16x4 vlo[8],vhi[8]; u32x4 pw0,pw1,pw2,pw3;
  #define PKW(P,B) cvtpk_s(P[B],P[B+1])
  #define PAF(k) __builtin_bit_cast(bf16x8,pw##k)
  #define VFR(i) (bf16x8){vlo[i][0],vlo[i][1],vlo[i][2],vlo[i][3],vhi[i][0],vhi[i][1],vhi[i][2],vhi[i][3]}
  #define PIN(x) asm volatile("":"+v"(x))
  #define MX3(a,b,c) __builtin_fmaxf(__builtin_fmaxf((a),(b)),(c))
  #define GAPA(MF,A0,A1,A2,A3,W0,W1,PW) do{ MF; sacc+=A0; sacc+=A1; sacc+=A2; sacc+=A3; PIN(sacc); W0; W1; PIN(PW); SBAR(); }while(0)
  #define EX(v) __builtin_amdgcn_exp2f(v)
  #define GAPB(MF,X,B) do{ MF; X[B]=EX(X[B]); X[B+1]=EX(X[B+1]); X[B+2]=EX(X[B+2]); X[B+3]=EX(X[B+3]); PIN(X); SBAR(); }while(0)
  #define VRD(i) do{ vlo[i]=vtr(vp_+(((i)>>2)*4096+((i)&3)*1024)); vhi[i]=vtr(vp_+(((i)>>2)*4096+((i)&3)*1024+512)); }while(0)
  #define KRD(G,j) do{ if(G){ kload2(kf,kp0+sl_next,j); SBAR(); } }while(0)
  #define STEP(C0,C1,P0,P1,t,GK,GV,GL) do{ SBAR(); \
    const lds_cptr vp_=vp0+sl_prev; \
    VRD(0); SBAR(); float sacc=(P0[0]+P0[1]); \
    GAPA(C0=__builtin_amdgcn_mfma_f32_32x32x16_bf16(kf[0],qr[0],negm,0,0,0), P0[2],P0[3],P0[4],P0[5],     pw0[0]=PKW(P0,0), pw0[1]=PKW(P0,2), pw0); \
    VRD(4); SBAR(); GAPA(C1=__builtin_amdgcn_mfma_f32_32x32x16_bf16(kf[1],qr[0],negm,0,0,0), P0[6],P0[7],P0[8],P0[9],     pw0[2]=PKW(P0,4), pw0[3]=PKW(P0,6), pw0); \
    VRD(1); SBAR(); GAPA(C0=__builtin_amdgcn_mfma_f32_32x32x16_bf16(kf[2],qr[1],C0,0,0,0),   P0[10],P0[11],P0[12],P0[13], pw1[0]=PKW(P0,8), pw1[1]=PKW(P0,10), pw1); \
    VRD(5); SBAR(); GAPA(C1=__builtin_amdgcn_mfma_f32_32x32x16_bf16(kf[3],qr[1],C1,0,0,0),   P0[14],P0[15],P1[0],P1[1],   pw1[2]=PKW(P0,12),pw1[3]=PKW(P0,14), pw1); \
    VRD(2); SBAR(); GAPA(C0=__builtin_amdgcn_mfma_f32_32x32x16_bf16(kf[4],qr[2],C0,0,0,0),   P1[2],P1[3],P1[4],P1[5],     pw2[0]=PKW(P1,0), pw2[1]=PKW(P1,2), pw2); \
    VRD(6); SBAR(); GAPA(C1=__builtin_amdgcn_mfma_f32_32x32x16_bf16(kf[5],qr[2],C1,0,0,0),   P1[6],P1[7],P1[8],P1[9],     pw2[2]=PKW(P1,4), pw2[3]=PKW(P1,6), pw2); \
    VRD(3); SBAR(); GAPA(C0=__builtin_amdgcn_mfma_f32_32x32x16_bf16(kf[6],qr[3],C0,0,0,0),   P1[10],P1[11],P1[12],P1[13], pw3[0]=PKW(P1,8), pw3[1]=PKW(P1,10), pw3); \
    VRD(7); SBAR(); GAPA(C1=__builtin_amdgcn_mfma_f32_32x32x16_bf16(kf[7],qr[3],C1,0,0,0),   P1[14],P1[15],0.f,0.f,       pw3[2]=PKW(P1,12),pw3[3]=PKW(P1,14), pw3); \
    l_reg+=sacc; \
    if(GK){DMA_K((t)+3,sl_cur);} if(GV){DMA_V((t)+1,sl_next);} \
    CMASK(C0,C1,t); \
    { float a=MX3(C0[0],C0[1],C1[0]),b=MX3(C0[2],C0[3],C1[1]); a=MX3(a,C1[2],C1[3]); \
      _Pragma("unroll") for(int r=4;r<16;r+=4){a=MX3(a,C0[r],C0[r+1]);b=MX3(b,C0[r+2],C0[r+3]);a=MX3(a,C1[r],C1[r+1]);b=MX3(b,C1[r+2],C1[r+3]);} \
      float rm=__builtin_fmaxf(a,b); { auto rr=__builtin_amdgcn_permlane32_swap(__float_as_uint(rm),__float_as_uint(rm),false,false); rm=__builtin_fmaxf(__uint_as_float(rr[0]),__uint_as_float(rr[1])); } \
      resc=false; \
      if(__builtin_expect(__any(rm>(float)THRL),0)){ const float dl=__builtin_fmaxf(rm,0.f); mhat+=dl; \
        _Pragma("unroll") for(int r=0;r<16;++r){C0[r]-=dl;C1[r]-=dl;} \
        _Pragma("unroll") for(int r=0;r<16;++r)negm[r]=-mhat; asm volatile("":"+v"(negm)); \
        const float f=__builtin_amdgcn_exp2f(-dl); l_reg*=f; if(hi==0)wsf[r32]=f; resc=true; } } \
    SBAR(); \
    GAPB(o[0]=__builtin_amdgcn_mfma_f32_32x32x16_bf16(PAF(0),VFR(0),o[0],0,0,0), C0,0); \
    GAPB(o[1]=__builtin_amdgcn_mfma_f32_32x32x16_bf16(PAF(0),VFR(4),o[1],0,0,0), C0,4); \
    KRD(GL,0); GAPB(o[0]=__builtin_amdgcn_mfma_f32_32x32x16_bf16(PAF(1),VFR(1),o[0],0,0,0), C0,8); \
    KRD(GL,1); GAPB(o[1]=__builtin_amdgcn_mfma_f32_32x32x16_bf16(PAF(1),VFR(5),o[1],0,0,0), C0,12); \
    KRD(GL,2); GAPB(o[0]=__builtin_amdgcn_mfma_f32_32x32x16_bf16(PAF(2),VFR(2),o[0],0,0,0), C1,0); \
    KRD(GL,3); GAPB(o[1]=__builtin_amdgcn_mfma_f32_32x32x16_bf16(PAF(2),VFR(6),o[1],0,0,0), C1,4); \
    GAPB(o[0]=__builtin_amdgcn_mfma_f32_32x32x16_bf16(PAF(3),VFR(3),o[0],0,0,0), C1,8); \
    GAPB(o[1]=__builtin_amdgcn_mfma_f32_32x32x16_bf16(PAF(3),VFR(7),o[1],0,0,0), C1,12); \
    }while(0)
  int t=1;
  #undef CMASK
  #define CMASK(P0,P1,t) do{}while(0)
  for(;t+5<NT;t+=2){
    STEP(pB0,pB1,pA0,pA1,t,true,true,true);     WAIT_BAR(2); RESC(); ROT();
    STEP(pA0,pA1,pB0,pB1,t+1,true,true,true);   WAIT_BAR(2); RESC(); ROT();
  }
  #undef CMASK
  #define CMASK(P0,P1,t) do{int jb_=(t)-(NT-4); if(jb_>=0)cmask(P0,P1,jb_,qrel,hi);}while(0)
  #define ENDW(tt) do{ if((tt)+3<NT){WAIT_BAR(2);} else if((tt)+2<NT){WAIT_BAR(1);} else {WAIT_BAR(0);} }while(0)
  for(;t+1<NT;t+=2){
    STEP(pB0,pB1,pA0,pA1,t,(t+3<NT),(t+1<NT),(t+1<NT));       ENDW(t);   RESC(); ROT();
    STEP(pA0,pA1,pB0,pB1,t+1,(t+4<NT),(t+2<NT),(t+2<NT));     ENDW(t+1); RESC(); ROT();
  }
  STEP(pB0,pB1,pA0,pA1,NT-1,false,false,false); RESC();
  { float sacc=pB0[0]+pB0[1]; _Pragma("unroll") for(int r=2;r<16;++r)sacc+=pB0[r]; _Pragma("unroll") for(int r=0;r<16;++r)sacc+=pB1[r]; l_reg+=sacc;
    pw0=(u32x4){PKW(pB0,0),PKW(pB0,2),PKW(pB0,4),PKW(pB0,6)};pw1=(u32x4){PKW(pB0,8),PKW(pB0,10),PKW(pB0,12),PKW(pB0,14)};pw2=(u32x4){PKW(pB1,0),PKW(pB1,2),PKW(pB1,4),PKW(pB1,6)};pw3=(u32x4){PKW(pB1,8),PKW(pB1,10),PKW(pB1,12),PKW(pB1,14)};
    SBAR(); pv(o,vb0+sl_cur,PAF(0),PAF(1),PAF(2),PAF(3)); }
  #undef PKW
  #undef PAF
  #undef VFR
  #undef PIN
  #undef MX3
  #undef GAPA
  #undef GAPB
  #undef EX
  #undef VRD
  #undef KRD
  #undef STEP
  #undef ENDW
  {auto rr=__builtin_amdgcn_permlane32_swap(__float_as_uint(l_reg),__float_as_uint(l_reg),false,false);l_reg=__uint_as_float(rr[0])+__uint_as_float(rr[1]);}
  if(hi==0)wsf[32+r32]=l_reg;asm volatile("s_waitcnt lgkmcnt(0)":::"memory");
  float rli[16];
  #pragma unroll
  for(int r=0;r<16;++r)rli[r]=__builtin_amdgcn_rcpf(wsf[32+crow(r,hi)]);
  bf16*Ow=Oh+(long)(q0+wid*QBLK)*OP;
  { bf16*stg=(bf16*)(shm+LDS_OST)+wid*2048;
    #pragma unroll
    for(int r=0;r<16;++r){const int orow=crow(r,hi);
      #pragma unroll
      for(int d0=0;d0<2;++d0)stg[orow*64+d0*32+r32]=__float2bfloat16(o[d0][r]*rli[r]);}
    asm volatile("s_waitcnt lgkmcnt(0)":::"memory");
    #pragma unroll
    for(int i=0;i<4;++i){const int row=i*8+(lane>>3),ch=lane&7; const u32x4 v=*(const u32x4*)(stg+row*64+ch*8); ATTN_STORE16(Ow+(long)row*OP+ch*8,v);} }
  asm volatile("s_waitcnt lgkmcnt(0)\n\ts_barrier":::"memory");
  #undef DMA_K
  #undef DMA_V
  #undef CMASK
  #undef START
  #undef RESC
  #undef ROT
}
constexpr int ATTN_LDS_BYTES=LDS_BYTES;
#undef SBAR
#undef WAIT_BAR
}

namespace sb_body {
using bf16x8 = __attribute__((ext_vector_type(8))) short;
using s16x4 = __attribute__((ext_vector_type(4))) short;
using f32x16 = __attribute__((ext_vector_type(16))) float;
using u32x4 = __attribute__((ext_vector_type(4))) unsigned;
typedef unsigned short bfu;
typedef short v4i16_t __attribute__((ext_vector_type(4)));
#define SB_LAS __attribute__((address_space(3)))
constexpr int SLOT = 8192, LDS_K = 0, LDS_V = 2 * SLOT, LDS_FLAG = 4 * SLOT, LDS_BYTES = 4 * SLOT + 64;
constexpr float DONE_THR = 64.f;
__device__ __forceinline__ unsigned cvtpk(float lo, float hi) { typedef float f2 __attribute__((ext_vector_type(2))); typedef __bf16 b2 __attribute__((ext_vector_type(2))); f2 v = {lo, hi}; b2 b = __builtin_convertvector(v, b2); return __builtin_bit_cast(unsigned, b); }
__device__ __forceinline__ s16x4 vtr(const SB_LAS unsigned char* p) { return __builtin_bit_cast(s16x4, __builtin_amdgcn_ds_read_tr16_b64_v4i16((SB_LAS v4i16_t*)p)); }
__device__ __forceinline__ int crow(int r, int hi) { return (r & 3) + 8 * (r >> 2) + 4 * hi; }
__device__ __forceinline__ unsigned short f2bf(float f) { unsigned u = __builtin_bit_cast(unsigned, f); return (unsigned short)((u + 0x7fffu + ((u >> 16) & 1u)) >> 16); }

__device__ __forceinline__ void sb_unit(int q0, const bfu* Qh, const bfu* Kh, const bfu* Vh, bfu* Oh, const float* gn, SB_LAS unsigned char* lds, const int wave_s) {
    const int lane_l = lane_id_opaque(); const int lane = lane_l, r32 = lane & 31, hi = lane >> 5; int wid_l = wave_s; asm volatile("" : "+s"(wid_l)); const int wid = wid_l;
    const int qw0 = q0 + 32 * wid, qpos = qw0 + r32, qhi = qw0 + 31;
    const int NT = (q0 + 256) / 64;
    bf16x8 qr[4];
#pragma unroll
    for (int d0 = 0; d0 < 4; ++d0) qr[d0] = *(const bf16x8*)(Qh + (size_t)qpos * 512 + d0 * 16 + hi * 8);
    const bfu* ksrc = Kh + (size_t)lane * 512 + wid * 8;
    const bfu* vsrc = Vh + (size_t)(16 * (wid & 3) + (lane >> 2)) * 512 + (wid >> 2) * 32 + (lane & 3) * 8;
    SB_LAS unsigned char* kdst = lds + LDS_K + wid * 1024; SB_LAS unsigned char* vdst = lds + LDS_V + wid * 1024;
#define SB_ISSUE(t, b) do { __builtin_amdgcn_global_load_lds((const unsigned*)(ksrc + (size_t)(t) * 64 * 512), (SB_LAS unsigned*)(kdst + (b) * SLOT), 16, 0, 0); \
                            __builtin_amdgcn_global_load_lds((const unsigned*)(vsrc + (size_t)(t) * 64 * 512), (SB_LAS unsigned*)(vdst + (b) * SLOT), 16, 0, 0); } while (0)
    volatile SB_LAS int* flags = (volatile SB_LAS int*)(lds + LDS_FLAG);
    float zl_ = 0.f; asm volatile("" : "+v"(zl_));
    f32x16 o0, o1;
#pragma unroll
    for (int r = 0; r < 16; ++r) { o0[r] = zl_; o1[r] = zl_; }
    float carry = zl_;
    int buf = 0, it = 0;
    SB_ISSUE(NT - 1, 0);
    for (int t = NT - 1; ; --t, ++it, buf ^= 1) {
        asm volatile("s_waitcnt vmcnt(0)" ::: "memory"); __syncthreads();
        if (it > 0) { const int par = ((it - 1) & 1) * 8; int all = 1;
#pragma unroll
            for (int w = 0; w < 8; ++w) all &= flags[par + w];
            if (all) break; }
        if (t > 0) SB_ISSUE(t - 1, buf ^ 1);
        if (64 * t < qhi) {
            const SB_LAS unsigned char* kb = lds + LDS_K + buf * SLOT + hi * 1024 + r32 * 16;
            f32x16 p0, p1;
#pragma unroll
            for (int r = 0; r < 16; ++r) { p0[r] = zl_; p1[r] = zl_; }
#pragma unroll
            for (int d0 = 0; d0 < 4; ++d0) { const bf16x8 b0 = *(const SB_LAS bf16x8*)(kb + d0 * 2048), b1 = *(const SB_LAS bf16x8*)(kb + d0 * 2048 + 512);
                p0 = __builtin_amdgcn_mfma_f32_32x32x16_bf16(b0, qr[d0], p0, 0, 0, 0); p1 = __builtin_amdgcn_mfma_f32_32x32x16_bf16(b1, qr[d0], p1, 0, 0, 0); }
            const int kbase = 64 * t + 4 * hi;
            f32x16 s0, s1;
#pragma unroll
            for (int r = 0; r < 16; ++r) { const int kv = kbase + (r & 3) + 8 * (r >> 2);
                { const float z = p0[r]; const float sp = __builtin_fmaxf(z, 0.f) + __builtin_amdgcn_logf(1.0f + __builtin_amdgcn_exp2f(-__builtin_fabsf(z))); const bool ok = kv < qpos; s0[r] = ok ? sp : 0.f; p0[r] = ok ? z - sp : -INFINITY; }
                { const float z = p1[r]; const float sp = __builtin_fmaxf(z, 0.f) + __builtin_amdgcn_logf(1.0f + __builtin_amdgcn_exp2f(-__builtin_fabsf(z))); const bool ok = kv + 32 < qpos; s1[r] = ok ? sp : 0.f; p1[r] = ok ? z - sp : -INFINITY; } }
            float gs[8], ev[8], od[8], suf[8];
#pragma unroll
            for (int j = 0; j < 4; ++j) { gs[j] = (s0[4 * j] + s0[4 * j + 1]) + (s0[4 * j + 2] + s0[4 * j + 3]); gs[4 + j] = (s1[4 * j] + s1[4 * j + 1]) + (s1[4 * j + 2] + s1[4 * j + 3]); }
#pragma unroll
            for (int g = 0; g < 8; ++g) { auto rr = __builtin_amdgcn_permlane32_swap(__float_as_uint(gs[g]), __float_as_uint(gs[g]), false, false); ev[g] = __uint_as_float(rr[0]); od[g] = __uint_as_float(rr[1]); }
            float acc = carry;
#pragma unroll
            for (int g = 7; g >= 0; --g) { const float so = acc; acc += od[g]; const float se = acc; acc += ev[g]; suf[g] = hi ? so : se; }
            carry = acc;
#pragma unroll
            for (int j = 0; j < 4; ++j) {
                { float c = suf[j]; p0[4 * j + 3] = __builtin_amdgcn_exp2f(p0[4 * j + 3] - c); c += s0[4 * j + 3]; p0[4 * j + 2] = __builtin_amdgcn_exp2f(p0[4 * j + 2] - c); c += s0[4 * j + 2];
                  p0[4 * j + 1] = __builtin_amdgcn_exp2f(p0[4 * j + 1] - c); c += s0[4 * j + 1]; p0[4 * j] = __builtin_amdgcn_exp2f(p0[4 * j] - c); }
                { float c = suf[4 + j]; p1[4 * j + 3] = __builtin_amdgcn_exp2f(p1[4 * j + 3] - c); c += s1[4 * j + 3]; p1[4 * j + 2] = __builtin_amdgcn_exp2f(p1[4 * j + 2] - c); c += s1[4 * j + 2];
                  p1[4 * j + 1] = __builtin_amdgcn_exp2f(p1[4 * j + 1] - c); c += s1[4 * j + 1]; p1[4 * j] = __builtin_amdgcn_exp2f(p1[4 * j] - c); } }
            u32x4 pw[4];
            pw[0] = (u32x4){cvtpk(p0[0], p0[1]), cvtpk(p0[2], p0[3]), cvtpk(p0[4], p0[5]), cvtpk(p0[6], p0[7])}; pw[1] = (u32x4){cvtpk(p0[8], p0[9]), cvtpk(p0[10], p0[11]), cvtpk(p0[12], p0[13]), cvtpk(p0[14], p0[15])};
            pw[2] = (u32x4){cvtpk(p1[0], p1[1]), cvtpk(p1[2], p1[3]), cvtpk(p1[4], p1[5]), cvtpk(p1[6], p1[7])}; pw[3] = (u32x4){cvtpk(p1[8], p1[9]), cvtpk(p1[10], p1[11]), cvtpk(p1[12], p1[13]), cvtpk(p1[14], p1[15])};
            const SB_LAS unsigned char* vp = lds + LDS_V + buf * SLOT + ((lane >> 4) & 1) * 32 + (lane & 3) * 8 + (4 * hi + ((lane & 15) >> 2)) * 64;
#pragma unroll
            for (int ks = 0; ks < 4; ++ks) {
                const s16x4 l0 = vtr(vp + ks * 1024), h0 = vtr(vp + ks * 1024 + 512), l1 = vtr(vp + 4096 + ks * 1024), h1 = vtr(vp + 4096 + ks * 1024 + 512);
                const bf16x8 v0 = (bf16x8){l0[0], l0[1], l0[2], l0[3], h0[0], h0[1], h0[2], h0[3]}, v1 = (bf16x8){l1[0], l1[1], l1[2], l1[3], h1[0], h1[1], h1[2], h1[3]};
                o0 = __builtin_amdgcn_mfma_f32_32x32x16_bf16(__builtin_bit_cast(bf16x8, pw[ks]), v0, o0, 0, 0, 0);
                o1 = __builtin_amdgcn_mfma_f32_32x32x16_bf16(__builtin_bit_cast(bf16x8, pw[ks]), v1, o1, 0, 0, 0); }
        }
        const int done = (t == 0) || __all(carry > DONE_THR);
        if (lane == 0) flags[(it & 1) * 8 + wid] = done ? 1 : 0;
        if (t == 0) break;
    }
    const float g0 = gn[r32], g1 = gn[32 + r32];
#pragma unroll
    for (int r = 0; r < 16; ++r) {
        float ss = o0[r] * o0[r] + o1[r] * o1[r];
        ss = red32(ss);
        const float inv = 1.0f / sqrtf(ss * (1.0f / 64.0f) + 1e-5f);
        bfu* op = Oh + (size_t)(qw0 + crow(r, hi)) * 1024 + r32;
        op[0] = f2bf(o0[r] * inv * g0); op[32] = f2bf(o1[r] * inv * g1);
    }
    __syncthreads();
#undef SB_ISSUE
}
#undef SB_LAS
}

namespace cg = cooperative_groups;
constexpr int NWAVES = 8;
constexpr int BATCH = 4, SEQ = 4096, D = 1024, M = BATCH * SEQ, DEPTH = 2;
constexpr int NE = 16, DFF = 512, PLE = 256, QKVW = 3072;
constexpr float LN_EPS = 1e-5f;
constexpr float ALPHA = 1.41421356237309515f;
constexpr float C2 = 0.125f * 1.4426950408889634f;

constexpr size_t MiB = 1u << 20;
constexpr size_t WS_CTL = 0, CTL_ZERO_BYTES = 1 * MiB;
constexpr size_t WS_PAIR = 1 * MiB;
constexpr size_t WS_GW = 2 * MiB;
constexpr size_t WS_CS = 3 * MiB;
constexpr size_t WS_WIN = 4 * MiB;
constexpr size_t WS_WO = 16 * MiB;
constexpr size_t WS_WGU = 20 * MiB;
constexpr size_t WS_WD = 84 * MiB;
constexpr size_t WS_WPG = 116 * MiB;
constexpr size_t WS_WPLE = 120 * MiB;
constexpr size_t WS_XA = 122 * MiB;
constexpr size_t WS_AO = 154 * MiB;
constexpr size_t WS_QKV = 186 * MiB;
constexpr size_t WS_H = WS_QKV;
constexpr size_t WS_YM = WS_QKV + 36 * MiB;
constexpr size_t WS_U = WS_QKV;
constexpr size_t WS_PB = 290 * MiB;
constexpr size_t WS_END = 306 * MiB;
constexpr size_t QKV_TSTRIDE = (size_t)M * 512;
constexpr int CW_CNT = 1024;
constexpr int CW_BAR = 4096;

constexpr int RING_OFF = 0, RING_BYTES = 131072;
constexpr int LDSCTL_OFF = RING_BYTES, MISC_OFF = LDSCTL_OFF + 320;
constexpr int MOETAB_OFF = LDSCTL_OFF + 512;
constexpr int TOK_OFF = LDSCTL_OFF + 1024;
constexpr int LDS_BYTES = 147456;
static_assert(TOK_OFF + 4096 <= LDS_BYTES, "LDS map");

#define GAS __attribute__((address_space(1)))
#define LAS __attribute__((address_space(3)))
typedef unsigned short bf16;
typedef unsigned v4u __attribute__((ext_vector_type(4)));
typedef float f32x4 __attribute__((ext_vector_type(4)));
typedef short bf16x8 __attribute__((ext_vector_type(8)));
typedef GAS unsigned gu32;
typedef GAS unsigned long long gu64;
#define RLX_AGENT __ATOMIC_RELAXED, __HIP_MEMORY_SCOPE_AGENT
#define LDS_WAIT() asm volatile("s_waitcnt lgkmcnt(0)" ::: "memory")
#define VM_WAIT() asm volatile("s_waitcnt vmcnt(0)" ::: "memory")
__device__ __forceinline__ unsigned long long rt() { return __builtin_amdgcn_s_memrealtime(); }
__device__ __forceinline__ unsigned f2bf(float f) { unsigned u = __builtin_bit_cast(unsigned, f); return (u + 0x7fffu + ((u >> 16) & 1u)) >> 16; }
__device__ __forceinline__ unsigned pk2(float lo, float hi) { return f2bf(lo) | (f2bf(hi) << 16); }

#define XB_TMO      128
#define XB_XCNT(j)  (256  + 64 * (j))
#define XB_XSUB(j)  (1280 + 64 * (j))
#define XB_XGEN(j)  (2304 + 64 * (j))
#define XB_TOP      3328
#define XB_TOPGEN   3392
#define XCD_BAR_WORDS 3456
#define XB_SPIN_CAP (1u << 18)

__device__ __forceinline__ unsigned xb_ld(unsigned* p)              { return __hip_atomic_load(p, __ATOMIC_RELAXED, __HIP_MEMORY_SCOPE_AGENT); }
__device__ __forceinline__ unsigned xb_add(unsigned* p, unsigned v) { return __hip_atomic_fetch_add(p, v, __ATOMIC_RELAXED, __HIP_MEMORY_SCOPE_AGENT); }
__device__ __forceinline__ unsigned xb_xcc_id() { return (unsigned)__builtin_amdgcn_s_getreg((3 << 11) | 20) & 0xFu; }
#define XB_SPIN(cond, bar) do { unsigned _sp = 0; while (cond) { __builtin_amdgcn_s_sleep(1); \
    if ((++_sp & 255u) == 0u) { if (xb_ld(&(bar)[XB_TMO])) break; if (_sp > XB_SPIN_CAP) { atomicAdd(&(bar)[XB_TMO], 1u); break; } } } } while (0)

struct XcdBarrier {
    unsigned* bar; unsigned x;
    volatile LAS unsigned* st;
};

__device__ __forceinline__ XcdBarrier xcd_barrier_post(unsigned* bar, volatile LAS unsigned* st) {
    XcdBarrier b; b.bar = bar; b.x = xb_xcc_id(); b.st = st;
    if (threadIdx.x == 0) (void)xb_add(&bar[XB_XCNT(b.x)], 1u);
    return b;
}
__device__ __forceinline__ void xcd_barrier_complete(unsigned* bar, unsigned x, unsigned& nloc, unsigned& nx) {
    const unsigned G = gridDim.x * gridDim.y * gridDim.z;
    unsigned sum, cnt, mine, sp = 0u;
    for (;;) {
        sum = 0u; cnt = 0u; mine = 0u;
#pragma unroll
        for (unsigned j = 0; j < 16; ++j) { const unsigned c = xb_ld(&bar[XB_XCNT(j)]); sum += c; cnt += (c > 0u) ? 1u : 0u; mine = (j == x) ? c : mine; }
        if (sum == G) break;
        __builtin_amdgcn_s_sleep(1);
        if ((++sp & 255u) == 0u) { if (xb_ld(&bar[XB_TMO])) break; if (sp > XB_SPIN_CAP) { atomicAdd(&bar[XB_TMO], 1u); break; } }
    }
    nloc = mine > 0u ? mine : 1u; nx = cnt > 0u ? cnt : 1u;
}

__device__ __forceinline__ void xcd_barrier(const XcdBarrier& b) {
    asm volatile("s_waitcnt vmcnt(0)" ::: "memory");
    __syncthreads();
    if (threadIdx.x == 0) {
        unsigned* bar = b.bar;
        __builtin_amdgcn_s_waitcnt(0);
        unsigned nloc = b.st[0], nx = b.st[1];
        if (nloc == 0u) { xcd_barrier_complete(bar, b.x, nloc, nx); b.st[0] = nloc; b.st[1] = nx; }
        const unsigned old = xb_add(&bar[XB_XSUB(b.x)], 1u);
        const unsigned gen = old / nloc;
        if (old + 1u == (gen + 1u) * nloc) {
            __builtin_amdgcn_fence(__ATOMIC_RELEASE, "agent");
            asm volatile("s_waitcnt vmcnt(0)" ::: "memory");
            const unsigned og = xb_add(&bar[XB_TOP], 1u);
            const unsigned tg = og / nx;
            if (og + 1u == (tg + 1u) * nx) xb_add(&bar[XB_TOPGEN], 1u);
            else XB_SPIN(xb_ld(&bar[XB_TOPGEN]) == tg, bar);
            __builtin_amdgcn_fence(__ATOMIC_ACQUIRE, "agent");
            xb_add(&bar[XB_XGEN(b.x)], 1u);
            asm volatile("s_waitcnt vmcnt(0)" ::: "memory");
        } else {
            XB_SPIN(xb_ld(&bar[XB_XGEN(b.x)]) == gen, bar);
            __builtin_amdgcn_fence(__ATOMIC_ACQUIRE, "agent");
            asm volatile("s_waitcnt vmcnt(0)" ::: "memory");
        }
    }
    __syncthreads();
}

__device__ __forceinline__ float wave_sum(float v) { return red64(v); }
__device__ __forceinline__ void p0_transpose_item(const float* W, int K, int N, bf16* WT, int dst_row0, int k0, int n0, LAS float* scr, int lane) {
#pragma unroll 8
    for (int i = 0; i < 32; ++i) { const int kk = 2 * i + (lane >> 5); scr[kk * 33 + (lane & 31)] = W[(size_t)(k0 + kk) * N + n0 + (lane & 31)]; }
    LDS_WAIT(); asm volatile("" ::: "memory");
    const int c = lane & 7;
#pragma unroll
    for (int j = 0; j < 4; ++j) { const int n = (lane >> 3) + 8 * j; const LAS float* s = scr + (8 * c) * 33 + n;
        v4u o; o.x = pk2(s[0 * 33], s[1 * 33]); o.y = pk2(s[2 * 33], s[3 * 33]); o.z = pk2(s[4 * 33], s[5 * 33]); o.w = pk2(s[6 * 33], s[7 * 33]);
        *(GAS v4u*)(WT + (size_t)(dst_row0 + n) * K + k0 + 8 * c) = o; }
    LDS_WAIT(); asm volatile("" ::: "memory");
}
__device__ __forceinline__ void ln_row(f32x4 (&v)[4], const float* g, const float* b, int lane) {
    float s = 0.f;
#pragma unroll
    for (int j = 0; j < 4; ++j) s += (v[j].x + v[j].y) + (v[j].z + v[j].w);
    const float mean = wave_sum(s) * (1.f / D); float s2 = 0.f;
#pragma unroll
    for (int j = 0; j < 4; ++j) { v[j] = v[j] - mean; s2 += (v[j].x * v[j].x + v[j].y * v[j].y) + (v[j].z * v[j].z + v[j].w * v[j].w); }
    const float rstd = 1.f / sqrtf(wave_sum(s2) * (1.f / D) + LN_EPS);
#pragma unroll
    for (int j = 0; j < 4; ++j) { const f32x4 gg = *(const f32x4*)(g + 4 * lane + 256 * j), bb = *(const f32x4*)(b + 4 * lane + 256 * j); v[j] = v[j] * rstd * gg + bb; }
}
__device__ __forceinline__ void store_row_bf16(bf16* orow, const f32x4 (&v)[4], int lane) {
    GAS unsigned long long* o8 = (GAS unsigned long long*)orow + lane;
#pragma unroll
    for (int j = 0; j < 4; ++j) o8[64 * j] = (unsigned long long)pk2(v[j].x, v[j].y) | ((unsigned long long)pk2(v[j].z, v[j].w) << 32);
}
typedef unsigned v2u __attribute__((ext_vector_type(2)));
__device__ __forceinline__ float bfl(unsigned w) { return __uint_as_float(w << 16); }
__device__ __forceinline__ float bfh(unsigned w) { return __uint_as_float(w & 0xffff0000u); }

#define KARG_OPEN() const char __attribute__((address_space(4)))* kp_ = (const char __attribute__((address_space(4)))*)__builtin_amdgcn_kernarg_segment_ptr(); asm volatile("" : "+s"(kp_))
#define KARG(T, k) (*(T const __attribute__((address_space(4)))*)(kp_ + 8 * (k)))
struct Args { const void* in[20]; float* out; unsigned char* ws; };
__global__ void __launch_bounds__(NWAVES * 64, 2) hymba_fwd(Args args) {
    extern __shared__ __attribute__((aligned(16))) unsigned char lds[];
    LAS unsigned char* const L = (LAS unsigned char*)lds;
    volatile LAS unsigned* const MISC = (volatile LAS unsigned*)(L + MISC_OFF);
    const int wave_s = __builtin_amdgcn_readfirstlane(threadIdx.x >> 6);
    const int G = gridDim.x; const int bx_k = blockIdx.x; const int vcu_k = (G % 8 == 0) ? (bx_k % 8) * (G / 8) + bx_k / 8 : bx_k;
#define PHASE_OPEN() KARG_OPEN(); unsigned char* const ws = KARG(unsigned char*, 21); float* const Y = KARG(float*, 20); (void)Y; \
    int bx_p = bx_k, vcu_p = vcu_k, wave_p = wave_s; asm volatile("" : "+s"(bx_p), "+s"(vcu_p), "+s"(wave_p)); const int bx = bx_p, vcu = vcu_p;     \
    const int lane = lane_id_opaque(), wave = wave_p, tid = wave * 64 + lane, gw = vcu * NWAVES + wave, NGW = G * NWAVES; (void)tid; (void)gw; (void)NGW; (void)bx
#define ctl ((gu32*)(ws + WS_CTL))
#define XA ((bf16*)(ws + WS_XA))
#define AO ((bf16*)(ws + WS_AO))
#define QKV ((bf16*)(ws + WS_QKV))
#define HB ((bf16*)(ws + WS_H))
#define YM ((bf16*)(ws + WS_YM))
#define UB ((bf16*)(ws + WS_U))
#define pairlist ((int*)(ws + WS_PAIR))
#define gwt ((float*)(ws + WS_GW))
#define cstab ((float*)(ws + WS_CS))
    for (int u = threadIdx.x; u < (LDS_BYTES - LDSCTL_OFF) / 4; u += NWAVES * 64) ((LAS unsigned*)(L + LDSCTL_OFF))[u] = 0u;
    __syncthreads();
    XcdBarrier bar; { PHASE_OPEN(); bar = xcd_barrier_post((unsigned*)(ctl + CW_BAR), MISC + 8); }
    cg::grid_group grid = cg::this_grid();
#define GRID_BAR() xcd_barrier(bar)

    {
        PHASE_OPEN();
        LAS float* scr = (LAS float*)(L + RING_OFF + wave * 16384);
        const float* w_in = KARG(const float*, 3); const float* w_o = KARG(const float*, 4); const float* w_gate = KARG(const float*, 14); const float* w_up = KARG(const float*, 15);
        const float* w_down = KARG(const float*, 16); const float* w_ple = KARG(const float*, 17); const float* w_pg = KARG(const float*, 18);
        bf16* Win_t = (bf16*)(ws + WS_WIN); bf16* Wo_t = (bf16*)(ws + WS_WO); bf16* Wgu_t = (bf16*)(ws + WS_WGU); bf16* Wd_t = (bf16*)(ws + WS_WD); bf16* Wpg_t = (bf16*)(ws + WS_WPG); bf16* Wple_t = (bf16*)(ws + WS_WPLE);
        constexpr int I_IN = 16 * 96, I_O = 16 * 32, I_G = 16 * 16, I_D = 8 * 32, I_PLE = 4 * 32, I_PG = 16 * 32;
        constexpr int N_IN = DEPTH * I_IN, N_O = DEPTH * I_O, N_G = DEPTH * NE * I_G, N_D = DEPTH * NE * I_D, N_PLE = DEPTH * I_PLE, N_PG = DEPTH * I_PG;
        constexpr int NITEMS = N_IN + N_O + 2 * N_G + N_D + N_PLE + N_PG;
        for (int it = gw; it < NITEMS; it += NGW) {
            int r = it;
            if (r < N_IN) { const int mt = r / I_IN, q = r % I_IN, kb = q / 96, nb = q % 96; p0_transpose_item(w_in + (size_t)mt * D * QKVW, D, QKVW, Win_t + (size_t)mt * QKVW * D, 32 * nb, 64 * kb, 32 * nb, scr, lane); continue; } r -= N_IN;
            if (r < N_O) { const int mt = r / I_O, q = r % I_O, kb = q / 32, nb = q % 32; p0_transpose_item(w_o + (size_t)mt * D * D, D, D, Wo_t + (size_t)mt * D * D, 32 * nb, 64 * kb, 32 * nb, scr, lane); continue; } r -= N_O;
            if (r < N_G) { const int mt = r / I_G, q = r % I_G, kb = q / 16, nb = q % 16, n0 = 32 * nb; p0_transpose_item(w_gate + (size_t)mt * D * DFF, D, DFF, Wgu_t + (size_t)mt * D * D, (n0 >> 7) * 256 + (n0 & 127), 64 * kb, n0, scr, lane); continue; } r -= N_G;
            if (r < N_G) { const int mt = r / I_G, q = r % I_G, kb = q / 16, nb = q % 16, n0 = 32 * nb; p0_transpose_item(w_up + (size_t)mt * D * DFF, D, DFF, Wgu_t + (size_t)mt * D * D, (n0 >> 7) * 256 + 128 + (n0 & 127), 64 * kb, n0, scr, lane); continue; } r -= N_G;
            if (r < N_D) { const int mt = r / I_D, q = r % I_D, kb = q / 32, nb = q % 32; p0_transpose_item(w_down + (size_t)mt * DFF * D, DFF, D, Wd_t + (size_t)mt * D * DFF, 32 * nb, 64 * kb, 32 * nb, scr, lane); continue; } r -= N_D;
            if (r < N_PLE) { const int mt = r / I_PLE, q = r % I_PLE, kb = q / 32, nb = q % 32; p0_transpose_item(w_ple + (size_t)mt * PLE * D, PLE, D, Wple_t + (size_t)mt * D * PLE, 32 * nb, 64 * kb, 32 * nb, scr, lane); continue; } r -= N_PLE;
            { const int mt = r / I_PG, q = r % I_PG, kb = q / 32, nb = q % 32; p0_transpose_item(w_pg + (size_t)mt * D * D, D, D, Wpg_t + (size_t)mt * D * D, 32 * nb, 64 * kb, 32 * nb, scr, lane); }
        }
        const float* x = KARG(const float*, 0);
        for (int m = gw; m < M; m += NGW) {
            f32x4 v[4];
#pragma unroll
            for (int j = 0; j < 4; ++j) v[j] = *(const f32x4*)(x + (size_t)m * D + 4 * lane + 256 * j);
            store_row_bf16(XA + (size_t)m * D, v, lane);
        }
        const float* pin = KARG(const float*, 1); bf16* PB = (bf16*)(ws + WS_PB);
        for (int m = gw; m < DEPTH * M; m += NGW) {
            const f32x4 v = *(const f32x4*)(pin + (size_t)m * PLE + 4 * lane);
            *((GAS unsigned long long*)(PB + (size_t)m * PLE) + lane) = (unsigned long long)pk2(v.x, v.y) | ((unsigned long long)pk2(v.z, v.w) << 32);
        }
        const int* pos = KARG(const int*, 2);
        for (int i = bx * (NWAVES * 64) + tid; i < M * 8; i += G * NWAVES * 64) {
            const int tok = i >> 3, f = i & 7;
            const float invf = exp2f(-(float)f * 0.125f * 18.931568569324174f);
            const double rev = (double)pos[tok] * (double)invf * 0.15915494309189535;
            const float fr = (float)(rev - floor(rev));
            cstab[(size_t)tok * 16 + f] = __builtin_amdgcn_cosf(fr); cstab[(size_t)tok * 16 + 8 + f] = __builtin_amdgcn_sinf(fr);
        }
    }
    asm volatile("s_waitcnt vmcnt(0)" ::: "memory");
    grid.sync();

    for (int layer = 0; layer < DEPTH; ++layer) {
#define LWIN ((const bf16*)(ws + WS_WIN) + (size_t)layer * QKVW * D)
#define LWO ((const bf16*)(ws + WS_WO) + (size_t)layer * D * D)
#define LWGU ((const bf16*)(ws + WS_WGU) + (size_t)layer * NE * D * D)
#define LWD ((const bf16*)(ws + WS_WD) + (size_t)layer * NE * D * DFF)
#define LWPG ((const bf16*)(ws + WS_WPG) + (size_t)layer * D * D)
#define LWPLE ((const bf16*)(ws + WS_WPLE) + (size_t)layer * D * PLE)
#define LAMBDA_INIT (0.8f - 0.6f * expf(-0.3f * (float)layer))

        {
            PHASE_OPEN();
            pg8::Gemm g{layer == 0 ? XA : AO, LWIN, M, QKVW, D}; pg8::StaticOrder S; S.init(M, QKVW, G, bx);
            pg8::EpiQKV E{QKV, QKV_TSTRIDE, cstab, C2};
            pg8::gemm_phase<pg8::EpiQKV, pg8::StaticOrder, true, true, false>(L + RING_OFF, g, S, E, wave_s);
        }
        GRID_BAR();

        {
            PHASE_OPEN();
            const bf16* QS = QKV; const bf16* KS = QKV + QKV_TSTRIDE; const bf16* VS = QKV + 2 * QKV_TSTRIDE;
            const bf16* QD = QKV + 3 * QKV_TSTRIDE; const bf16* KD = QKV + 4 * QKV_TSTRIDE; const bf16* VD = QKV + 5 * QKV_TSTRIDE;
            {
                const int combo = vcu >> 2, s = vcu & 3, bh = combo >> 2, c = (combo >> 1) & 1, vh = combo & 1, b = bh >> 2, h = bh & 3;
                const attn_body::bf16* Qh = (const attn_body::bf16*)(QD + (size_t)b * SEQ * 512 + (h * 2 + c) * 64);
                const attn_body::bf16* Kh = (const attn_body::bf16*)(KD + (size_t)b * SEQ * 512 + (h * 2 + c) * 64);
                const attn_body::bf16* Vh = (const attn_body::bf16*)(VD + (size_t)b * SEQ * 512 + h * 128 + vh * 64);
                attn_body::bf16* Oh = (attn_body::bf16*)(XA + (size_t)b * SEQ * 1024 + (h * 2 + c) * 128 + vh * 64);
                for (int i = 0; i < 4; ++i) { const int qb = (i == 0) ? 15 - s : (i == 1) ? 8 + s : (i == 2) ? 7 - s : s;
                    attn_body::attn_unit<8, 512, 512, 1024>(qb, Qh, Kh, Vh, Oh, (char*)lds + RING_OFF, wave_s); }
            }
            {
                const int bh = vcu >> 3, s = vcu & 7, b = bh >> 3, h = bh & 7;
                const float* gsb = KARG(const float*, 5) + layer * 64;
                for (int i = 0; i < 2; ++i) { const int qb = i ? s : 15 - s;
                    sb_body::sb_unit(qb * 256, QS + (size_t)b * SEQ * 512 + h * 64, KS + (size_t)b * SEQ * 512 + h * 64, VS + (size_t)b * SEQ * 512 + h * 64, AO + (size_t)b * SEQ * 1024 + h * 64, gsb, L + RING_OFF, wave_s); }
            }
        }
        GRID_BAR();

        {
            PHASE_OPEN();
            const float* lp = KARG(const float*, 6) + layer * 256;
            const float lambda_init = LAMBDA_INIT; const float lam = expf(wave_sum(lp[lane] * lp[64 + lane])) - expf(wave_sum(lp[128 + lane] * lp[192 + lane])) + lambda_init;
            const float* gda = KARG(const float*, 7) + layer * 128;
            const int hh = lane >> 4, sub = lane & 15; const float gsc = 1.0f - lambda_init;
            const f32x4 ga = *(const f32x4*)(gda + sub * 8), gb = *(const f32x4*)(gda + sub * 8 + 4);
            for (int m = gw; m < M; m += NGW) {
                const v4u a = *(const GAS v4u*)(XA + (size_t)m * 1024 + (hh * 2) * 128 + sub * 8), c2 = *(const GAS v4u*)(XA + (size_t)m * 1024 + (hh * 2 + 1) * 128 + sub * 8);
                float v[8];
                v[0] = bfl(a.x) - lam * bfl(c2.x); v[1] = bfh(a.x) - lam * bfh(c2.x); v[2] = bfl(a.y) - lam * bfl(c2.y); v[3] = bfh(a.y) - lam * bfh(c2.y);
                v[4] = bfl(a.z) - lam * bfl(c2.z); v[5] = bfh(a.z) - lam * bfh(c2.z); v[6] = bfl(a.w) - lam * bfl(c2.w); v[7] = bfh(a.w) - lam * bfh(c2.w);
                float ss = 0.f;
#pragma unroll
                for (int e = 0; e < 8; ++e) ss += v[e] * v[e];
                ss = red16(ss);
                const float inv = gsc / sqrtf(ss * (1.0f / 128.0f) + LN_EPS);
                v4u o; o.x = pk2(v[0] * inv * ga.x, v[1] * inv * ga.y); o.y = pk2(v[2] * inv * ga.z, v[3] * inv * ga.w); o.z = pk2(v[4] * inv * gb.x, v[5] * inv * gb.y); o.w = pk2(v[6] * inv * gb.z, v[7] * inv * gb.w);
                *(GAS v4u*)(AO + (size_t)m * 1024 + 512 + hh * 128 + sub * 8) = o;
            }
        }
        GRID_BAR();

        {
            PHASE_OPEN();
            pg8::Gemm g{AO, LWO, M, D, D}; pg8::StaticOrder S; S.init(M, D, G, bx);
            pg8::EpiOut E{layer == 0 ? KARG(const float*, 0) : (const float*)Y, Y, ALPHA};
            pg8::gemm_phase<pg8::EpiOut, pg8::StaticOrder, true, true, false>(L + RING_OFF, g, S, E, wave_s);
        }
        GRID_BAR();

        {
            PHASE_OPEN();
            LAS float* RWT = (LAS float*)(L + RING_OFF);
            LAS int* lcnt = (LAS int*)(L + RING_OFF + 65536);
            LAS int* gbase = lcnt + 16;
            LAS int* r_e = lcnt + 32;
            LAS int* r_ls = lcnt + 160;
            LAS float* r_g = (LAS float*)(lcnt + 288);
            const float* rw = KARG(const float*, 12); const float* rb = KARG(const float*, 13);
            const float* g1 = KARG(const float*, 8) + layer * D; const float* b1 = KARG(const float*, 9) + layer * D;
            for (int idx = tid; idx < D * NE; idx += NWAVES * 64) RWT[(idx & 15) * 1024 + (idx >> 4)] = rw[idx];
            float rbv[16];
#pragma unroll
            for (int e = 0; e < 16; ++e) rbv[e] = rb[e];
            for (int chunk = bx; chunk < M / 64; chunk += G) {
                if (tid < 16) lcnt[tid] = 0;
                __syncthreads();
                for (int i = 0; i < 8; ++i) {
                    const int rl = wave * 8 + i, m = chunk * 64 + rl;
                    f32x4 v[4];
#pragma unroll
                    for (int j = 0; j < 4; ++j) v[j] = *(const f32x4*)(Y + (size_t)m * D + 4 * lane + 256 * j);
                    ln_row(v, g1, b1, lane);
#pragma unroll
                    for (int j = 0; j < 4; ++j) *(f32x4*)(Y + (size_t)m * D + 4 * lane + 256 * j) = v[j];
                    store_row_bf16(XA + (size_t)m * D, v, lane);
                    float sc[16], sel[16];
#pragma unroll
                    for (int e = 0; e < 16; ++e) { float s = 0.f;
#pragma unroll
                        for (int j = 0; j < 4; ++j) { const f32x4 w = *(const LAS f32x4*)(RWT + e * 1024 + 256 * j + 4 * lane); s += (v[j].x * w.x + v[j].y * w.y) + (v[j].z * w.z + v[j].w * w.w); }
                        s = wave_sum(s); sc[e] = 1.0f / (1.0f + expf(-s)); sel[e] = sc[e] + rbv[e]; }
                    float gsc[4];
#pragma unroll
                    for (int gI = 0; gI < 4; ++gI) { const float a = sel[4 * gI], bq = sel[4 * gI + 1], cq = sel[4 * gI + 2], dq = sel[4 * gI + 3];
                        const float h1 = fmaxf(a, bq), l1 = fminf(a, bq), h2 = fmaxf(cq, dq), l2 = fminf(cq, dq); gsc[gI] = fmaxf(h1, h2) + fmaxf(fminf(h1, h2), fmaxf(l1, l2)); }
                    int grp = 0; float best = gsc[0];
#pragma unroll
                    for (int gI = 1; gI < 4; ++gI) if (gsc[gI] > best) { best = gsc[gI]; grp = gI; }
                    float s4[4], c4[4];
#pragma unroll
                    for (int j = 0; j < 4; ++j) { s4[j] = sel[j]; c4[j] = sc[j];
#pragma unroll
                        for (int gI = 1; gI < 4; ++gI) if (grp == gI) { s4[j] = sel[4 * gI + j]; c4[j] = sc[4 * gI + j]; } }
                    int i1 = 0; float m1 = s4[0];
#pragma unroll
                    for (int j = 1; j < 4; ++j) if (s4[j] > m1) { m1 = s4[j]; i1 = j; }
                    int i2 = -1; float m2 = 0.f;
#pragma unroll
                    for (int j = 0; j < 4; ++j) if (j != i1 && (i2 < 0 || s4[j] > m2)) { m2 = s4[j]; i2 = j; }
                    float ga1 = c4[0], ga2 = c4[0];
#pragma unroll
                    for (int j = 1; j < 4; ++j) { if (i1 == j) ga1 = c4[j]; if (i2 == j) ga2 = c4[j]; }
                    const float gs = 1.0f / (ga1 + ga2);
                    if (lane == 0) {
                        const int e1 = grp * 4 + i1, e2 = grp * 4 + i2;
                        r_e[rl * 2] = e1; r_e[rl * 2 + 1] = e2;
                        r_ls[rl * 2] = __hip_atomic_fetch_add(lcnt + e1, 1, __ATOMIC_RELAXED, __HIP_MEMORY_SCOPE_WORKGROUP);
                        r_ls[rl * 2 + 1] = __hip_atomic_fetch_add(lcnt + e2, 1, __ATOMIC_RELAXED, __HIP_MEMORY_SCOPE_WORKGROUP);
                        r_g[rl * 2] = ga1 * gs; r_g[rl * 2 + 1] = ga2 * gs;
                    }
                }
                __syncthreads();
                if (tid < 16) gbase[tid] = (int)__hip_atomic_fetch_add(ctl + CW_CNT + layer * 16 + tid, (unsigned)lcnt[tid], RLX_AGENT);
                __syncthreads();
                if (tid < 128) { const int e = r_e[tid], slot = gbase[e] + r_ls[tid]; pairlist[e * 16384 + slot] = 2 * (chunk * 64 + (tid >> 1)) + (tid & 1); gwt[e * 16384 + slot] = r_g[tid]; }
                __syncthreads();
            }
        }
        GRID_BAR();

        LAS int* const tab = (LAS int*)(L + MOETAB_OFF); LAS int* const tokt = (LAS int*)(L + TOK_OFF);
        {
            PHASE_OPEN();
            if (tid == 0) { int tb = 0;
                for (int e = 0; e < 16; ++e) { const int c = (int)__hip_atomic_load(ctl + CW_CNT + layer * 16 + e, RLX_AGENT); tab[e] = c; tab[16 + e] = tb; tb += (c + 255) >> 8; }
                tab[32] = tb; }
            __syncthreads();
            pg8::MoeOrder S{tab, tokt, G, bx};
            for (int k = 0; k < 4; ++k) { pg8::Unit u;
                if (S.next(k, u) && tid < 256) { const int e = u.pn >> 2, slot = (u.pm - tab[16 + e]) * 256 + tid; tokt[k * 256 + tid] = (slot < tab[e]) ? (pairlist[e * 16384 + slot] >> 1) : 0; } }
            __syncthreads();
            pg8::Gemm g{XA, LWGU, M, 0, D};
            pg8::EpiGateUp E{HB};
            pg8::gemm_phase<pg8::EpiGateUp, pg8::MoeOrder, true, true, true>(L + RING_OFF, g, S, E, wave_s);
        }
        GRID_BAR();

        {
            PHASE_OPEN();
            pg8::MoeOrder S{tab, tokt, G, bx};
            pg8::Gemm g{HB, LWD, 0, 0, DFF};
            pg8::EpiDown E{YM, pairlist, gwt, tab};
            pg8::gemm_phase<pg8::EpiDown, pg8::MoeOrder, true, true, false>(L + RING_OFF, g, S, E, wave_s);
        }
        GRID_BAR();

        {
            PHASE_OPEN();
            const float* g2 = KARG(const float*, 10) + layer * D; const float* b2 = KARG(const float*, 11) + layer * D;
            for (int m = gw; m < M; m += NGW) {
                f32x4 v[4];
#pragma unroll
                for (int j = 0; j < 4; ++j) { const f32x4 xv = *(const f32x4*)(Y + (size_t)m * D + 4 * lane + 256 * j);
                    const v2u ya = *(const GAS v2u*)(YM + (size_t)(2 * m) * D + 4 * lane + 256 * j), yb = *(const GAS v2u*)(YM + (size_t)(2 * m + 1) * D + 4 * lane + 256 * j);
                    v[j].x = xv.x * ALPHA + (bfl(ya.x) + bfl(yb.x)); v[j].y = xv.y * ALPHA + (bfh(ya.x) + bfh(yb.x)); v[j].z = xv.z * ALPHA + (bfl(ya.y) + bfl(yb.y)); v[j].w = xv.w * ALPHA + (bfh(ya.y) + bfh(yb.y)); }
                ln_row(v, g2, b2, lane);
#pragma unroll
                for (int j = 0; j < 4; ++j) *(f32x4*)(Y + (size_t)m * D + 4 * lane + 256 * j) = v[j];
                store_row_bf16(XA + (size_t)m * D, v, lane);
            }
        }
        GRID_BAR();

        {
            PHASE_OPEN();
            pg8::StaticOrder S; S.init(M, D, G, bx);
            { pg8::Gemm g{(const bf16*)(ws + WS_PB) + (size_t)layer * M * PLE, LWPLE, M, D, PLE}; pg8::EpiBf16Plain E{UB, D};
              pg8::gemm_phase<pg8::EpiBf16Plain, pg8::StaticOrder, true, true, false>(L + RING_OFF, g, S, E, wave_s); }
            { pg8::Gemm g{XA, LWPG, M, D, D}; pg8::EpiPle E{Y, UB, KARG(const float*, 19) + layer * D, AO};
              pg8::gemm_phase<pg8::EpiPle, pg8::StaticOrder, true, true, false>(L + RING_OFF, g, S, E, wave_s); }
        }
        if (layer + 1 < DEPTH) GRID_BAR();
    }
}

extern "C" void kernel_launch(void* const* d_in, const int* in_sizes, int n_in, void* d_out, int out_size, void* d_ws, size_t ws_size, hipStream_t stream) {
    static int grid = 0;
    if (grid == 0) {
        if (n_in != 20 || in_sizes[0] != M * D || out_size != M * D || ws_size < WS_END) { fprintf(stderr, "kernel_launch: built for 20 inputs, x and out of %d floats, >= %zu bytes of workspace; got n_in %d, in0 %d, out %d, ws %zu; nothing launched\n", M * D, (size_t)WS_END, n_in, n_in > 0 ? in_sizes[0] : -1, out_size, ws_size); grid = -1; return; }
        int dev = 0, cus = 0, per_cu = 0;
        if (hipGetDevice(&dev) != hipSuccess || hipDeviceGetAttribute(&cus, hipDeviceAttributeMultiprocessorCount, dev) != hipSuccess) { fprintf(stderr, "kernel_launch: hipGetDevice / hipDeviceGetAttribute failed; nothing launched\n"); grid = -1; return; }
        if (hipFuncSetAttribute((const void*)hymba_fwd, hipFuncAttributeMaxDynamicSharedMemorySize, LDS_BYTES) != hipSuccess) { fprintf(stderr, "kernel_launch: hipFuncSetAttribute failed\n"); grid = -1; return; }
        if (hipOccupancyMaxActiveBlocksPerMultiprocessor(&per_cu, (const void*)hymba_fwd, NWAVES * 64, LDS_BYTES) != hipSuccess || per_cu < 1) { fprintf(stderr, "kernel_launch: occupancy query reports %d workgroups per CU; nothing launched\n", per_cu); (void)hipGetLastError(); grid = -1; return; }
        if (cus < 256) { fprintf(stderr, "kernel_launch: this kernel's static unit orders need 256 resident workgroups (one per CU); the device has %d CUs; nothing launched\n", cus); grid = -1; return; }
        grid = 256;
    }
    if (grid < 0) return;
    if (hipMemsetAsync((char*)d_ws + WS_CTL, 0, CTL_ZERO_BYTES, stream) != hipSuccess) { fprintf(stderr, "kernel_launch: hipMemsetAsync of the control words failed; nothing launched\n"); return; }
    Args a{};
    for (int i = 0; i < 20; ++i) a.in[i] = d_in[i];
    a.out = (float*)d_out; a.ws = (unsigned char*)d_ws;
    void* kargs[] = {&a};
    const hipError_t le = hipLaunchCooperativeKernel((const void*)hymba_fwd, dim3(grid), dim3(NWAVES * 64), kargs, LDS_BYTES, stream);
    if (le != hipSuccess) fprintf(stderr, "kernel_launch: cooperative launch failed: %s (grid %d x %d threads, %d B LDS)\n", hipGetErrorName(le), grid, NWAVES * 64, LDS_BYTES);
}
```
